# Optimizing an MI355X kernel written in HIP

```python
import math
import jax
import jax.numpy as jnp
from jax import lax
import numpy as np

D_MODEL = 1024
BATCH = 4
SEQ = 4096
DEPTH = 2

RMS_EPS = 1e-6
L2_EPS = 1e-6
CHUNK = 64
CONV_K = 4

GDN_HEADS = 4
GDN_DK = 128
GDN_DV = 128
HGRN_HEADS = 4
HGRN_DK = 128
HGRN_DV = 128
RET_HEADS = 4
RET_DK = D_MODEL // RET_HEADS
RET_DV = 2 * RET_DK
ROPE_BASE = 10000.0
N_GROUPS = 4
EXPERTS_PER_GROUP = 4
N_EXPERTS = N_GROUPS * EXPERTS_PER_GROUP
D_EXPERT = 256
TOP_K_INNER = 2

N_EVEN = (DEPTH + 1) // 2
N_ODD = DEPTH // 2

GDN_QK_W = GDN_HEADS * GDN_DK
GDN_V_W = GDN_HEADS * GDN_DV
GDN_CONV_W = 2 * GDN_QK_W + GDN_V_W
HGRN_K_W = HGRN_HEADS * HGRN_DK
HGRN_V_W = HGRN_HEADS * HGRN_DV
EVEN_SPLITS = (GDN_CONV_W, GDN_V_W, GDN_HEADS, GDN_HEADS, HGRN_K_W, HGRN_K_W, HGRN_V_W, HGRN_V_W)
EVEN_IN = sum(EVEN_SPLITS)
EVEN_MIX_W = GDN_V_W + HGRN_V_W
RET_QK_W = RET_HEADS * RET_DK
RET_V_W = RET_HEADS * RET_DV
ODD_SPLITS = (RET_QK_W, RET_QK_W, RET_V_W, RET_V_W)
ODD_IN = sum(ODD_SPLITS)
ODD_MIX_W = RET_V_W

kernel_name = 'hybrid_gdn_hgrn2_retnet_hmoe'


def rms_norm(x, w):
    xf = x.astype(jnp.float32)
    xf = xf * lax.rsqrt(jnp.mean(xf * xf, axis=-1, keepdims=True) + RMS_EPS)
    return (xf * w.astype(jnp.float32)).astype(x.dtype)


def l2_normalize(x):
    xf = x.astype(jnp.float32)
    return (xf * lax.rsqrt(jnp.sum(xf * xf, axis=-1, keepdims=True) + L2_EPS)).astype(x.dtype)


def split_heads(x, n_heads):
    b, t, c = x.shape
    return x.reshape(b, t, n_heads, c // n_heads).transpose(0, 2, 1, 3)


def merge_heads(x):
    b, h, t, d = x.shape
    return x.transpose(0, 2, 1, 3).reshape(b, t, h * d)


def split_cols(p, sizes):
    idx = [int(i) for i in np.cumsum(sizes)[:-1]]
    return jnp.split(p, idx, axis=-1)


def to_chunks(x):
    b, h, t = x.shape[:3]
    x = x.reshape((b, h, t // CHUNK, CHUNK) + x.shape[3:])
    return jnp.moveaxis(x, 2, 0)


def from_chunks(y):
    n, b, h, c, d = y.shape
    return jnp.moveaxis(y, 0, 2).reshape(b, h, n * c, d)


def causal_short_conv(x, w):
    t = x.shape[1]
    xp = jnp.pad(x, ((0, 0), (CONV_K - 1, 0), (0, 0)))
    return sum(xp[:, j:j + t] * w[j] for j in range(CONV_K))


def rotary(x):
    t, d = x.shape[2], x.shape[3]
    inv = 1.0 / (ROPE_BASE ** jnp.linspace(0.0, 1.0, d // 2, dtype=jnp.float32))
    ang = jnp.arange(t, dtype=jnp.float32)[:, None] * inv[None, :]
    cos = jnp.cos(ang).astype(x.dtype)
    sin = jnp.sin(ang).astype(x.dtype)
    x1, x2 = x[..., 0::2], x[..., 1::2]
    return jnp.stack([x1 * cos - x2 * sin, x1 * sin + x2 * cos], axis=-1).reshape(x.shape)


def gated_delta_rule(q, k, v, beta, g):
    f32 = jnp.float32
    dk, dv = q.shape[-1], v.shape[-1]
    qc = to_chunks(q.astype(f32) * dk ** -0.5)
    kc = to_chunks(k.astype(f32))
    vc = to_chunks(v.astype(f32))
    bc = to_chunks(beta.astype(f32))[..., None]
    gc = jnp.cumsum(to_chunks(g.astype(f32)), axis=-1)
    causal = jnp.tril(jnp.ones((CHUNK, CHUNK), bool))
    decay = jnp.exp(jnp.where(causal, gc[..., :, None] - gc[..., None, :], -jnp.inf))
    a = jnp.tril(jnp.einsum('nbhid,nbhjd->nbhij', kc * bc, kc) * decay, -1)
    rhs = jnp.concatenate([vc * bc, kc * bc * jnp.exp(gc)[..., None]], axis=-1)
    sol = lax.linalg.triangular_solve(a, rhs, left_side=True, lower=True, unit_diagonal=True)
    u, w = sol[..., :dv], sol[..., dv:]

    def step(state, inp):
        q_i, k_i, u_i, w_i, g_i, d_i = inp
        v_new = u_i - jnp.einsum('bhck,bhkv->bhcv', w_i, state)
        attn = jnp.einsum('bhik,bhjk->bhij', q_i, k_i) * d_i
        o = (jnp.einsum('bhck,bhkv->bhcv', q_i * jnp.exp(g_i)[..., None], state)
             + jnp.einsum('bhij,bhjv->bhiv', attn, v_new))
        g_last = g_i[..., -1:]
        k_dec = k_i * jnp.exp(g_last - g_i)[..., None]
        state = state * jnp.exp(g_last)[..., None] + jnp.einsum('bhck,bhcv->bhkv', k_dec, v_new)
        return state, o

    s0 = jnp.zeros(qc.shape[1:3] + (dk, dv), f32)
    _, o = lax.scan(step, s0, (qc, kc, u, w, gc, decay))
    return from_chunks(o).astype(v.dtype)


def hgrn2_recurrence(q, k, i, log_f):
    f32 = jnp.float32
    dk, dv = q.shape[-1], i.shape[-1]
    qc = to_chunks(q.astype(f32) * dk ** -0.5)
    kc = to_chunks(k.astype(f32))
    ic = to_chunks(i.astype(f32))
    bc = jnp.cumsum(to_chunks(log_f.astype(f32)), axis=-2)
    causal = jnp.tril(jnp.ones((CHUNK, CHUNK), bool))[:, :, None]

    def step(state, inp):
        q_i, k_i, i_i, b_i = inp
        dmat = jnp.exp(jnp.where(causal, b_i[:, :, :, None, :] - b_i[:, :, None, :, :], -jnp.inf))
        attn = jnp.einsum('bhtk,bhsk,bhtsk->bhts', q_i, k_i, dmat)
        o = (jnp.einsum('bhtk,bhkv->bhtv', q_i * jnp.exp(b_i), state)
             + jnp.einsum('bhts,bhsv->bhtv', attn, i_i))
        b_last = b_i[:, :, -1:, :]
        state = (state * jnp.exp(b_last[:, :, 0, :])[..., None]
                 + jnp.einsum('bhsk,bhsv->bhkv', k_i * jnp.exp(b_last - b_i), i_i))
        return state, o

    s0 = jnp.zeros(qc.shape[1:3] + (dk, dv), f32)
    _, o = lax.scan(step, s0, (qc, kc, ic, bc))
    return from_chunks(o).astype(i.dtype)


def multiscale_retention(q, k, v):
    f32 = jnp.float32
    n_heads, dk, dv = q.shape[1], q.shape[-1], v.shape[-1]
    log_gamma = jnp.log(1.0 - 2.0 ** (-5.0 - jnp.arange(n_heads, dtype=f32)))
    pos = jnp.arange(CHUNK, dtype=f32)
    rel = pos[:, None] - pos[None, :]
    intra = jnp.where(rel >= 0, jnp.exp(jnp.maximum(rel, 0.0) * log_gamma[:, None, None]), 0.0)
    q_decay = jnp.exp((pos + 1.0) * log_gamma[:, None])[:, :, None]
    k_decay = jnp.exp((CHUNK - 1.0 - pos) * log_gamma[:, None])[:, :, None]
    chunk_decay = jnp.exp(CHUNK * log_gamma)[:, None, None]
    qc = to_chunks(q.astype(f32))
    kc = to_chunks(k.astype(f32) * dk ** -0.5)
    vc = to_chunks(v.astype(f32))

    def step(state, inp):
        q_i, k_i, v_i = inp
        attn = jnp.einsum('bhik,bhjk->bhij', q_i, k_i) * intra
        o = (jnp.einsum('bhck,bhkv->bhcv', q_i, state) * q_decay
             + jnp.einsum('bhij,bhjv->bhiv', attn, v_i))
        state = state * chunk_decay + jnp.einsum('bhck,bhcv->bhkv', k_i * k_decay, v_i)
        return state, o

    s0 = jnp.zeros(qc.shape[1:3] + (dk, dv), f32)
    _, o = lax.scan(step, s0, (qc, kc, vc))
    return from_chunks(o).astype(v.dtype)


def even_mixer(h, w_in, conv_w, a_log, dt_bias, gdn_norm_w, lower_bound, hgrn_norm_w, w_out):
    f32 = jnp.float32
    g_qkv, g_z, g_b, g_a, h_q, h_f, h_i, h_g = split_cols(h @ w_in, EVEN_SPLITS)
    qkv = jax.nn.silu(causal_short_conv(g_qkv, conv_w))
    q, k, v = split_cols(qkv, (GDN_QK_W, GDN_QK_W, GDN_V_W))
    q = l2_normalize(split_heads(q, GDN_HEADS))
    k = l2_normalize(split_heads(k, GDN_HEADS))
    v = split_heads(v, GDN_HEADS)
    beta = jax.nn.sigmoid(g_b.astype(f32)).transpose(0, 2, 1)
    g = (-jnp.exp(a_log.astype(f32)) * jax.nn.softplus(g_a.astype(f32) + dt_bias.astype(f32))).transpose(0, 2, 1)
    o_a = gated_delta_rule(q, k, v, beta, g)
    o_a = rms_norm(o_a, gdn_norm_w) * jax.nn.silu(split_heads(g_z, GDN_HEADS))
    f_gate = lower_bound + (1.0 - lower_bound) * jax.nn.sigmoid(h_f.astype(f32))
    o_b = hgrn2_recurrence(split_heads(jax.nn.silu(h_q), HGRN_HEADS),
                           split_heads((1.0 - f_gate).astype(h.dtype), HGRN_HEADS),
                           split_heads(h_i, HGRN_HEADS),
                           split_heads(jnp.log(f_gate), HGRN_HEADS))
    o_b = rms_norm(o_b, hgrn_norm_w) * jax.nn.silu(split_heads(h_g, HGRN_HEADS))
    return jnp.concatenate([merge_heads(o_a), merge_heads(o_b)], axis=-1) @ w_out


def retention_mixer(h, w_in, norm_w, w_out):
    q, k, v, g = split_cols(h @ w_in, ODD_SPLITS)
    q = rotary(split_heads(q, RET_HEADS))
    k = rotary(split_heads(k, RET_HEADS))
    o = multiscale_retention(q, k, split_heads(v, RET_HEADS))
    o = rms_norm(o, norm_w) * jax.nn.silu(split_heads(g, RET_HEADS))
    return merge_heads(o) @ w_out


def hierarchical_moe(h, wc, bc, wf, bf, w_gate_up, w_down):
    b, t, d = h.shape
    xt = h.reshape(b * t, d)
    n = xt.shape[0]
    coarse_prob = jax.nn.softmax((xt @ wc + bc).astype(jnp.float32), axis=-1)
    g_prob, g_idx = lax.top_k(coarse_prob, 1)
    fine_logits = (xt @ wf + bf).astype(jnp.float32).reshape(n, N_GROUPS, EXPERTS_PER_GROUP)
    fine_sel = jnp.take_along_axis(fine_logits, g_idx[:, :, None], axis=1)[:, 0]
    e_logit, e_idx = lax.top_k(fine_sel, TOP_K_INNER)
    e_w = jax.nn.softmax(e_logit, axis=-1) * g_prob
    expert_id = g_idx * EXPERTS_PER_GROUP + e_idx
    gates = jnp.sum(jax.nn.one_hot(expert_id, N_EXPERTS, dtype=jnp.float32) * e_w[..., None], axis=1)
    gu = jnp.einsum('nd,edf->nef', xt, w_gate_up)
    gate, up = jnp.split(gu, 2, axis=-1)
    act = jax.nn.silu(gate) * up * gates.astype(h.dtype)[..., None]
    return jnp.einsum('nef,efd->nd', act, w_down).reshape(b, t, d)


def setup_inputs(seed: int = 0) -> dict:
    key = jax.random.key(seed)
    ks = jax.random.split(key, 24)
    f32 = jnp.float32

    def normal(k, shape, scale):
        return scale * jax.random.normal(k, shape, f32)

    def gain(k, shape):
        return 1.0 + 0.02 * jax.random.normal(k, shape, f32)

    dt = jnp.exp(jax.random.uniform(ks[6], (N_EVEN, GDN_HEADS), f32, math.log(1e-3), math.log(1e-1)))
    return {
        'x': normal(ks[0], (BATCH, SEQ, D_MODEL), 1.0),
        'norm_mix_w': gain(ks[1], (DEPTH, D_MODEL)),
        'norm_ffn_w': gain(ks[2], (DEPTH, D_MODEL)),
        'even_w_in': normal(ks[3], (N_EVEN, D_MODEL, EVEN_IN), D_MODEL ** -0.5),
        'gdn_conv_w': normal(ks[4], (N_EVEN, CONV_K, GDN_CONV_W), CONV_K ** -0.5),
        'gdn_a_log': jnp.log(jax.random.uniform(ks[5], (N_EVEN, GDN_HEADS), f32, 1.0, 16.0)),
        'gdn_dt_bias': dt + jnp.log(-jnp.expm1(-dt)),
        'gdn_norm_w': gain(ks[7], (N_EVEN, GDN_DV)),
        'hgrn_lb_logits': normal(ks[8], (DEPTH + 1, HGRN_K_W), 0.1),
        'hgrn_norm_w': gain(ks[9], (N_EVEN, HGRN_DV)),
        'even_w_out': normal(ks[10], (N_EVEN, EVEN_MIX_W, D_MODEL), EVEN_MIX_W ** -0.5),
        'odd_w_in': normal(ks[11], (N_ODD, D_MODEL, ODD_IN), D_MODEL ** -0.5),
        'ret_norm_w': gain(ks[12], (N_ODD, RET_DV)),
        'odd_w_out': normal(ks[13], (N_ODD, ODD_MIX_W, D_MODEL), ODD_MIX_W ** -0.5),
        'router_c_w': normal(ks[14], (DEPTH, D_MODEL, N_GROUPS), D_MODEL ** -0.5),
        'router_c_b': normal(ks[15], (DEPTH, N_GROUPS), 0.01),
        'router_f_w': normal(ks[16], (DEPTH, D_MODEL, N_EXPERTS), D_MODEL ** -0.5),
        'router_f_b': normal(ks[17], (DEPTH, N_EXPERTS), 0.01),
        'moe_w_gate_up': normal(ks[18], (DEPTH, N_EXPERTS, D_MODEL, 2 * D_EXPERT), D_MODEL ** -0.5),
        'moe_w_down': normal(ks[19], (DEPTH, N_EXPERTS, D_EXPERT, D_MODEL), D_EXPERT ** -0.5),
        'final_norm_w': gain(ks[20], (D_MODEL,)),
    }


def reference(x, norm_mix_w, norm_ffn_w, even_w_in, gdn_conv_w, gdn_a_log, gdn_dt_bias, gdn_norm_w,
              hgrn_lb_logits, hgrn_norm_w, even_w_out, odd_w_in, ret_norm_w, odd_w_out,
              router_c_w, router_c_b, router_f_w, router_f_b, moe_w_gate_up, moe_w_down, final_norm_w):
    lower_bounds = jnp.cumsum(jax.nn.softmax(hgrn_lb_logits.astype(jnp.float32), axis=0), axis=0)
    for layer in range(DEPTH):
        j = layer // 2
        h = rms_norm(x, norm_mix_w[layer])
        if layer % 2 == 0:
            mix = even_mixer(h, even_w_in[j], gdn_conv_w[j], gdn_a_log[j], gdn_dt_bias[j], gdn_norm_w[j],
                             lower_bounds[layer], hgrn_norm_w[j], even_w_out[j])
        else:
            mix = retention_mixer(h, odd_w_in[j], ret_norm_w[j], odd_w_out[j])
        x = x + mix
        h = rms_norm(x, norm_ffn_w[layer])
        x = x + hierarchical_moe(h, router_c_w[layer], router_c_b[layer], router_f_w[layer], router_f_b[layer],
                                 moe_w_gate_up[layer], moe_w_down[layer])
    return rms_norm(x, final_norm_w)
```

```cpp
#include <hip/hip_runtime.h>
#include <cstdint>
#include <cstdio>

#define D_MODEL 1024
#define BATCH 4
#define SEQ 4096
#define NTOK (BATCH * SEQ)
#define EVEN_IN 4104
#define ODD_IN 6144

__device__ __forceinline__ float sigmoidf_(float x) { return 1.0f / (1.0f + __expf(-x)); }
__device__ __forceinline__ float siluf_(float x) { return x / (1.0f + __expf(-x)); }
__device__ __forceinline__ float softplusf_(float x) { return x > 20.f ? x : log1pf(__expf(x)); }

__device__ __forceinline__ float block_sum_256(float v, float* red) {
    for (int o = 32; o > 0; o >>= 1) v += __shfl_xor(v, o);
    __syncthreads();
    if ((threadIdx.x & 63) == 0) red[threadIdx.x >> 6] = v;
    __syncthreads();
    float r = red[0] + red[1] + red[2] + red[3];
    return r;
}

__global__ void __launch_bounds__(256) k_rmsnorm(const float* x, const float* __restrict__ w, float* out) {
    __shared__ float red[8];
    const int row = blockIdx.x, t = threadIdx.x;
    const float4 v = ((const float4*)(x + (size_t)row * D_MODEL))[t];
    float s = v.x * v.x + v.y * v.y + v.z * v.z + v.w * v.w;
    s = block_sum_256(s, red);
    const float rs = rsqrtf(s * (1.0f / D_MODEL) + 1e-6f);
    const float4 ww = ((const float4*)w)[t];
    float4 o; o.x = v.x * rs * ww.x; o.y = v.y * rs * ww.y; o.z = v.z * rs * ww.z; o.w = v.w * rs * ww.w;
    ((float4*)(out + (size_t)row * D_MODEL))[t] = o;
}

__global__ void __launch_bounds__(256) k_sgemm(const float* __restrict__ A, const float* __restrict__ B, float* __restrict__ C,
                                               const float* __restrict__ R, int M, int N, int K) {
    __shared__ float As[16][128 + 4];
    __shared__ float Bs[16][128 + 4];
    const int tid = threadIdx.x;
    const int bm = blockIdx.y * 128, bn = blockIdx.x * 128;
    const int tx = tid & 15, ty = tid >> 4;
    float acc[8][8];
#pragma unroll
    for (int i = 0; i < 8; ++i)
#pragma unroll
        for (int j = 0; j < 8; ++j) acc[i][j] = 0.f;
    for (int k0 = 0; k0 < K; k0 += 16) {
#pragma unroll
        for (int i = 0; i < 8; ++i) {
            const int idx = tid + i * 256;
            const int r = idx >> 4, c = idx & 15;
            As[c][r] = A[(size_t)(bm + r) * K + k0 + c];
        }
#pragma unroll
        for (int i = 0; i < 8; ++i) {
            const int idx = tid + i * 256;
            const int r = idx >> 7, c = idx & 127;
            const int gc = bn + c;
            Bs[r][c] = gc < N ? B[(size_t)(k0 + r) * N + gc] : 0.f;
        }
        __syncthreads();
#pragma unroll
        for (int kk = 0; kk < 16; ++kk) {
            float a[8], b[8];
#pragma unroll
            for (int i = 0; i < 8; ++i) a[i] = As[kk][ty * 8 + i];
#pragma unroll
            for (int j = 0; j < 8; ++j) b[j] = Bs[kk][tx * 8 + j];
#pragma unroll
            for (int i = 0; i < 8; ++i)
#pragma unroll
                for (int j = 0; j < 8; ++j) acc[i][j] = fmaf(a[i], b[j], acc[i][j]);
        }
        __syncthreads();
    }
#pragma unroll
    for (int i = 0; i < 8; ++i) {
        const int r = bm + ty * 8 + i;
#pragma unroll
        for (int j = 0; j < 8; ++j) {
            const int c = bn + tx * 8 + j;
            if (c < N) {
                float v = acc[i][j];
                if (R) v += R[(size_t)r * N + c];
                C[(size_t)r * N + c] = v;
            }
        }
    }
}

__global__ void __launch_bounds__(256) k_even_prep(const float* __restrict__ P, const float* __restrict__ conv_w, const float* __restrict__ a_log,
                                                   const float* __restrict__ dt_bias, const float* __restrict__ lb_logits,
                                                   float* __restrict__ gq, float* __restrict__ gk, float* __restrict__ gv, float* __restrict__ gbeta, float* __restrict__ gg,
                                                   float* __restrict__ hq, float* __restrict__ hlf, float* __restrict__ hk) {
    __shared__ float qkv[1536];
    __shared__ float nrm[8];
    const int tok = blockIdx.x, t = threadIdx.x;
    const int tt = tok % SEQ;
    for (int c = t; c < 1536; c += 256) {
        float s = 0.f;
#pragma unroll
        for (int j = 0; j < 4; ++j) {
            const int ts = tt - 3 + j;
            if (ts >= 0) s += P[(size_t)(tok - 3 + j) * EVEN_IN + c] * conv_w[j * 1536 + c];
        }
        qkv[c] = siluf_(s);
    }
    __syncthreads();
    {
        const int g = t >> 5, l = t & 31;
        float s = 0.f;
#pragma unroll
        for (int i = 0; i < 4; ++i) { const float v = qkv[g * 128 + l + 32 * i]; s += v * v; }
        for (int o = 16; o > 0; o >>= 1) s += __shfl_xor(s, o);
        if (l == 0) nrm[g] = rsqrtf(s + 1e-6f);
    }
    __syncthreads();
    for (int c = t; c < 512; c += 256) {
        gq[(size_t)tok * 512 + c] = qkv[c] * nrm[c >> 7];
        gk[(size_t)tok * 512 + c] = qkv[512 + c] * nrm[4 + (c >> 7)];
        gv[(size_t)tok * 512 + c] = qkv[1024 + c];
    }
    if (t < 4) {
        const float b = P[(size_t)tok * EVEN_IN + 2048 + t];
        const float a = P[(size_t)tok * EVEN_IN + 2052 + t];
        gbeta[(size_t)tok * 4 + t] = sigmoidf_(b);
        gg[(size_t)tok * 4 + t] = -__expf(a_log[t]) * softplusf_(a + dt_bias[t]);
    }
    for (int c = t; c < 512; c += 256) {
        const float l0 = lb_logits[c], l1 = lb_logits[512 + c], l2 = lb_logits[1024 + c];
        const float mx = fmaxf(l0, fmaxf(l1, l2));
        const float e0 = __expf(l0 - mx), e1 = __expf(l1 - mx), e2 = __expf(l2 - mx);
        const float lb = e0 / (e0 + e1 + e2);
        const float q = P[(size_t)tok * EVEN_IN + 2056 + c];
        const float f = P[(size_t)tok * EVEN_IN + 2568 + c];
        const float fg = lb + (1.f - lb) * sigmoidf_(f);
        hq[(size_t)tok * 512 + c] = siluf_(q);
        hlf[(size_t)tok * 512 + c] = fg;
        hk[(size_t)tok * 512 + c] = 1.f - fg;
    }
}

__global__ void __launch_bounds__(128) k_gdn_rec(const float* __restrict__ gq, const float* __restrict__ gk, const float* __restrict__ gv,
                                                 const float* __restrict__ gbeta, const float* __restrict__ gg, float* __restrict__ o) {
    const int b = 0, h = blockIdx.x, c = threadIdx.x;
    float S[128];
#pragma unroll
    for (int i = 0; i < 128; ++i) S[i] = 0.f;
    const float scale = 0.08838834764831845f;
    for (int t = 0; t < SEQ; ++t) {
        const size_t tok = (size_t)b * SEQ + t;
        const float* __restrict__ kp = gk + tok * 512 + h * 128;
        const float* __restrict__ qp = gq + tok * 512 + h * 128;
        const float a = __expf(gg[tok * 4 + h]);
        const float be = gbeta[tok * 4 + h];
        const float v = gv[tok * 512 + h * 128 + c];
        float ks = 0.f;
#pragma unroll
        for (int i = 0; i < 128; ++i) { S[i] *= a; ks = fmaf(kp[i], S[i], ks); }
        const float r = be * (v - ks);
        float oo = 0.f;
#pragma unroll
        for (int i = 0; i < 128; ++i) { S[i] = fmaf(kp[i], r, S[i]); oo = fmaf(qp[i], S[i], oo); }
        o[tok * 512 + h * 128 + c] = oo * scale;
    }
}

__global__ void __launch_bounds__(128) k_hgrn_rec(const float* __restrict__ hq, const float* __restrict__ hf, const float* __restrict__ hk,
                                                  const float* __restrict__ P, float* __restrict__ o) {
    const int b = 0, h = blockIdx.x, c = threadIdx.x;
    float S[128];
#pragma unroll
    for (int i = 0; i < 128; ++i) S[i] = 0.f;
    const float scale = 0.08838834764831845f;
    for (int t = 0; t < SEQ; ++t) {
        const size_t tok = (size_t)b * SEQ + t;
        const float* __restrict__ fp = hf + tok * 512 + h * 128;
        const float* __restrict__ kp = hk + tok * 512 + h * 128;
        const float* __restrict__ qp = hq + tok * 512 + h * 128;
        const float iv = P[tok * EVEN_IN + 3080 + h * 128 + c];
        float oo = 0.f;
#pragma unroll
        for (int i = 0; i < 128; ++i) { S[i] = fmaf(fp[i], S[i], kp[i] * iv); oo = fmaf(qp[i], S[i], oo); }
        o[tok * 512 + h * 128 + c] = oo * scale;
    }
}

__global__ void __launch_bounds__(256) k_even_post(const float* __restrict__ oa, const float* __restrict__ ob, const float* __restrict__ P,
                                                   const float* __restrict__ gnw, const float* __restrict__ hnw, float* __restrict__ A) {
    const int tok = blockIdx.x, t = threadIdx.x;
    const int hd = t >> 5, l = t & 31;
    const float* src = hd < 4 ? oa + (size_t)tok * 512 + hd * 128 : ob + (size_t)tok * 512 + (hd - 4) * 128;
    const float* nw = hd < 4 ? gnw : hnw;
    const int gate_off = hd < 4 ? 1536 + hd * 128 : 3592 + (hd - 4) * 128;
    float v[4]; float s = 0.f;
#pragma unroll
    for (int i = 0; i < 4; ++i) { v[i] = src[l + 32 * i]; s += v[i] * v[i]; }
    for (int o = 16; o > 0; o >>= 1) s += __shfl_xor(s, o);
    const float rs = rsqrtf(s * (1.f / 128.f) + 1e-6f);
#pragma unroll
    for (int i = 0; i < 4; ++i) {
        const int cc = l + 32 * i;
        const float z = P[(size_t)tok * EVEN_IN + gate_off + cc];
        A[(size_t)tok * 1024 + hd * 128 + cc] = v[i] * rs * nw[cc] * siluf_(z);
    }
}

__global__ void __launch_bounds__(256) k_moe(const float* __restrict__ x, const float* __restrict__ nw, const float* __restrict__ wc, const float* __restrict__ bc,
                                             const float* __restrict__ wf, const float* __restrict__ bf, const float* __restrict__ wgu, const float* __restrict__ wd,
                                             float* __restrict__ out) {
    __shared__ float hs[1024];
    __shared__ float act[256];
    __shared__ float red[8];
    __shared__ float logits[20];
    __shared__ int sel_e[2];
    __shared__ float sel_w[2];
    const int tok = blockIdx.x, t = threadIdx.x;
    const float4 v = ((const float4*)(x + (size_t)tok * D_MODEL))[t];
    float s = v.x * v.x + v.y * v.y + v.z * v.z + v.w * v.w;
    s = block_sum_256(s, red);
    const float rs = rsqrtf(s * (1.0f / D_MODEL) + 1e-6f);
    const float4 ww = ((const float4*)nw)[t];
    hs[4 * t + 0] = v.x * rs * ww.x; hs[4 * t + 1] = v.y * rs * ww.y; hs[4 * t + 2] = v.z * rs * ww.z; hs[4 * t + 3] = v.w * rs * ww.w;
    __syncthreads();
    if (t < 20) {
        float a = 0.f;
        if (t < 4) { for (int k = 0; k < 1024; ++k) a = fmaf(hs[k], wc[k * 4 + t], a); a += bc[t]; }
        else { const int e = t - 4; for (int k = 0; k < 1024; ++k) a = fmaf(hs[k], wf[k * 16 + e], a); a += bf[e]; }
        logits[t] = a;
    }
    __syncthreads();
    if (t == 0) {
        float mx = logits[0]; int gi = 0;
        for (int i = 1; i < 4; ++i) if (logits[i] > mx) { mx = logits[i]; gi = i; }
        float den = 0.f;
        for (int i = 0; i < 4; ++i) den += __expf(logits[i] - mx);
        const float gprob = 1.f / den;
        const float* fl = logits + 4 + gi * 4;
        int e0 = 0; float m0 = fl[0];
        for (int i = 1; i < 4; ++i) if (fl[i] > m0) { m0 = fl[i]; e0 = i; }
        int e1 = -1; float m1 = -3.0e38f;
        for (int i = 0; i < 4; ++i) if (i != e0 && fl[i] > m1) { m1 = fl[i]; e1 = i; }
        const float p1 = __expf(m1 - m0);
        sel_e[0] = gi * 4 + e0; sel_e[1] = gi * 4 + e1;
        sel_w[0] = gprob / (1.f + p1); sel_w[1] = gprob * p1 / (1.f + p1);
    }
    __syncthreads();
    float o4[4] = {0.f, 0.f, 0.f, 0.f};
    for (int s2 = 0; s2 < 2; ++s2) {
        const int e = sel_e[s2];
        const float gw = sel_w[s2];
        const float* W = wgu + (size_t)e * 1024 * 512;
        float g = 0.f, u = 0.f;
        for (int k = 0; k < 1024; ++k) { const float hv = hs[k]; g = fmaf(hv, W[(size_t)k * 512 + t], g); u = fmaf(hv, W[(size_t)k * 512 + 256 + t], u); }
        __syncthreads();
        act[t] = siluf_(g) * u * gw;
        __syncthreads();
        const float* Wd = wd + (size_t)e * 256 * 1024;
        for (int f = 0; f < 256; ++f) {
            const float a = act[f];
#pragma unroll
            for (int i = 0; i < 4; ++i) o4[i] = fmaf(a, Wd[(size_t)f * 1024 + t + 256 * i], o4[i]);
        }
    }
#pragma unroll
    for (int i = 0; i < 4; ++i) out[(size_t)tok * D_MODEL + t + 256 * i] = x[(size_t)tok * D_MODEL + t + 256 * i] + o4[i];
}

__global__ void __launch_bounds__(256) k_odd_prep(const float* __restrict__ P, float* __restrict__ rq, float* __restrict__ rk) {
    const int tok = blockIdx.x, t = threadIdx.x;
    const int tt = tok % SEQ;
    for (int p = t; p < 512; p += 256) {
        const int i = p & 127;
        const float lin = (float)i / 127.0f;
        const float inv = 1.0f / powf(10000.0f, lin);
        const float ang = (float)tt * inv;
        float sn, cs; sincosf(ang, &sn, &cs);
        const float q1 = P[(size_t)tok * ODD_IN + 2 * p], q2 = P[(size_t)tok * ODD_IN + 2 * p + 1];
        rq[(size_t)tok * 1024 + 2 * p] = q1 * cs - q2 * sn; rq[(size_t)tok * 1024 + 2 * p + 1] = q1 * sn + q2 * cs;
        const float k1 = P[(size_t)tok * ODD_IN + 1024 + 2 * p], k2 = P[(size_t)tok * ODD_IN + 1024 + 2 * p + 1];
        rk[(size_t)tok * 1024 + 2 * p] = (k1 * cs - k2 * sn) * 0.0625f; rk[(size_t)tok * 1024 + 2 * p + 1] = (k1 * sn + k2 * cs) * 0.0625f;
    }
}

__global__ void __launch_bounds__(256) k_ret_rec(const float* __restrict__ rq, const float* __restrict__ rk, const float* __restrict__ P,
                                                 float* __restrict__ o  ) {
    __shared__ float red[2][128];
    const int blk = blockIdx.x;
    const int h = blk >> 2, cg = blk & 3;
    const int half = threadIdx.x >> 7, cl = threadIdx.x & 127, c = cg * 128 + cl;
    const float gamma = 1.0f - exp2f(-5.0f - (float)h);
    float S[128];
#pragma unroll
    for (int i = 0; i < 128; ++i) S[i] = 0.f;
    for (int t = 0; t < SEQ; ++t) {
        const size_t tok = (size_t)t;
        const float* __restrict__ kp = rk + tok * 1024 + h * 256 + half * 128;
        const float* __restrict__ qp = rq + tok * 1024 + h * 256 + half * 128;
        const float v = P[tok * ODD_IN + 2048 + h * 512 + c];
        float oo = 0.f;
#pragma unroll
        for (int i = 0; i < 128; ++i) { S[i] = fmaf(gamma, S[i], kp[i] * v); oo = fmaf(qp[i], S[i], oo); }
        if (half == 1) red[t & 1][cl] = oo;
        __syncthreads();
        if (half == 0) o[tok * 2048 + h * 512 + c] = oo + red[t & 1][cl];
    }
}

__global__ void __launch_bounds__(256) k_odd_post(const float* __restrict__ o, const float* __restrict__ P, const float* __restrict__ nw, float* __restrict__ A) {
    const int tok = blockIdx.x, t = threadIdx.x;
    const int hd = t >> 6, l = t & 63;
    float v[8]; float s = 0.f;
#pragma unroll
    for (int i = 0; i < 8; ++i) {
        const int cc = hd * 512 + l + 64 * i;
        v[i] = o[(size_t)tok * 2048 + cc];
        s += v[i] * v[i];
    }
    for (int o = 32; o > 0; o >>= 1) s += __shfl_xor(s, o);
    const float rs = rsqrtf(s * (1.f / 512.f) + 1e-6f);
#pragma unroll
    for (int i = 0; i < 8; ++i) {
        const int cc = l + 64 * i;
        const float z = P[(size_t)tok * ODD_IN + 4096 + hd * 512 + cc];
        A[(size_t)tok * 2048 + hd * 512 + cc] = v[i] * rs * nw[cc] * siluf_(z);
    }
}

extern "C" void kernel_launch(void* const* d_in, const int* in_sizes, int n_in, void* d_out, int out_size, void* d_ws, size_t ws_size, hipStream_t stream) {
    const float* x = (const float*)d_in[0];
    const float* norm_mix_w = (const float*)d_in[1];
    const float* norm_ffn_w = (const float*)d_in[2];
    const float* even_w_in = (const float*)d_in[3];
    const float* gdn_conv_w = (const float*)d_in[4];
    const float* gdn_a_log = (const float*)d_in[5];
    const float* gdn_dt_bias = (const float*)d_in[6];
    const float* gdn_norm_w = (const float*)d_in[7];
    const float* hgrn_lb = (const float*)d_in[8];
    const float* hgrn_norm_w = (const float*)d_in[9];
    const float* even_w_out = (const float*)d_in[10];
    const float* odd_w_in = (const float*)d_in[11];
    const float* ret_norm_w = (const float*)d_in[12];
    const float* odd_w_out = (const float*)d_in[13];
    const float* router_c_w = (const float*)d_in[14];
    const float* router_c_b = (const float*)d_in[15];
    const float* router_f_w = (const float*)d_in[16];
    const float* router_f_b = (const float*)d_in[17];
    const float* moe_gu = (const float*)d_in[18];
    const float* moe_dn = (const float*)d_in[19];
    const float* final_w = (const float*)d_in[20];
    float* out = (float*)d_out;

    float* ws = (float*)d_ws;
    size_t off = 0;
    auto alloc = [&](size_t n) { float* p = ws + off; off += (n + 63) & ~(size_t)63; return p; };
    float* x1 = alloc((size_t)NTOK * 1024);
    float* P = alloc((size_t)SEQ * ODD_IN);
    float* hA = alloc((size_t)SEQ * 1024);
    float* R = alloc((size_t)SEQ * 512 * 8);
    float* gbeta = alloc((size_t)SEQ * 4);
    float* gg = alloc((size_t)SEQ * 4);
    const size_t SL = (size_t)SEQ * 512;
    float *b0 = R, *b1 = R + SL, *b2 = R + 2 * SL, *b3 = R + 3 * SL, *b4 = R + 4 * SL, *b5 = R + 5 * SL;
    float* oa = R + 6 * SL; float* ob = R + 7 * SL;
    float* oo = R + 4 * SL;
    float* A1 = R;
    if (off * 4 > ws_size) { fprintf(stderr, "ws too small: need %zu have %zu\n", off * 4, ws_size); return; }
    float* x2 = out;

    for (int b = 0; b < BATCH; ++b) {
        const size_t ro = (size_t)b * SEQ * 1024;
        k_rmsnorm<<<SEQ, 256, 0, stream>>>(x + ro, norm_mix_w, hA);
        k_sgemm<<<dim3((EVEN_IN + 127) / 128, SEQ / 128), 256, 0, stream>>>(hA, even_w_in, P, nullptr, SEQ, EVEN_IN, 1024);
        k_even_prep<<<SEQ, 256, 0, stream>>>(P, gdn_conv_w, gdn_a_log, gdn_dt_bias, hgrn_lb, b0, b1, b2, gbeta, gg, b3, b4, b5);
        k_gdn_rec<<<4, 128, 0, stream>>>(b0, b1, b2, gbeta, gg, oa);
        k_hgrn_rec<<<4, 128, 0, stream>>>(b3, b4, b5, P, ob);
        k_even_post<<<SEQ, 256, 0, stream>>>(oa, ob, P, gdn_norm_w, hgrn_norm_w, hA);
        k_sgemm<<<dim3(1024 / 128, SEQ / 128), 256, 0, stream>>>(hA, even_w_out, x1 + ro, x + ro, SEQ, 1024, 1024);
    }
    k_moe<<<NTOK, 256, 0, stream>>>(x1, norm_ffn_w, router_c_w, router_c_b, router_f_w, router_f_b, moe_gu, moe_dn, x2);
    for (int b = 0; b < BATCH; ++b) {
        const size_t ro = (size_t)b * SEQ * 1024;
        k_rmsnorm<<<SEQ, 256, 0, stream>>>(x2 + ro, norm_mix_w + 1024, hA);
        k_sgemm<<<dim3(ODD_IN / 128, SEQ / 128), 256, 0, stream>>>(hA, odd_w_in, P, nullptr, SEQ, ODD_IN, 1024);
        k_odd_prep<<<SEQ, 256, 0, stream>>>(P, b0, b2);
        k_ret_rec<<<16, 256, 0, stream>>>(b0, b2, P, oo);
        k_odd_post<<<SEQ, 256, 0, stream>>>(oo, P, ret_norm_w, A1);
        k_sgemm<<<dim3(1024 / 128, SEQ / 128), 256, 0, stream>>>(A1, odd_w_out, x1 + ro, x2 + ro, SEQ, 1024, 2048);
    }
    k_moe<<<NTOK, 256, 0, stream>>>(x1, norm_ffn_w + 1024, router_c_w + 1024 * 4, router_c_b + 4, router_f_w + 1024 * 16, router_f_b + 16,
                                    moe_gu + (size_t)16 * 1024 * 512, moe_dn + (size_t)16 * 256 * 1024, x2);
    k_rmsnorm<<<NTOK, 256, 0, stream>>>(x2, final_w, out);
}
```

```cpp
#include <hip/hip_runtime.h>
#include <hip/hip_cooperative_groups.h>
#include <cstdint>
#include <cstdio>
namespace cg = cooperative_groups;

#define D_MODEL 1024
#define BATCH 4
#define SEQ 4096
#define NTOK (BATCH * SEQ)
#define EVEN_IN 4104
#define ODD_IN 6144
#define NTHREADS 512
#define NWAVES 8

__device__ __forceinline__ float sigmoidf_(float x) { return 1.0f / (1.0f + __expf(-x)); }
__device__ __forceinline__ float siluf_(float x) { return x / (1.0f + __expf(-x)); }
__device__ __forceinline__ float softplusf_(float x) { return x > 20.f ? x : log1pf(__expf(x)); }
__device__ __forceinline__ float bf2f(unsigned short b) { return __uint_as_float(((unsigned)b) << 16); }
__device__ __forceinline__ float wave_sum(float v) { for (int o = 32; o > 0; o >>= 1) v += __shfl_xor(v, o); return v; }

namespace g8 {
#define G8_LAS __attribute__((address_space(3)))
typedef unsigned short bf16_t;
typedef short bf16x8 __attribute__((ext_vector_type(8)));
typedef float f32x4 __attribute__((ext_vector_type(4)));
typedef unsigned u32x4 __attribute__((ext_vector_type(4)));
typedef unsigned u32x2 __attribute__((ext_vector_type(2)));
constexpr int BM = 256, BK = 64, HALF = 128, HTB = HALF * BK * 2, STAGE_BYTES = 8 * HTB;

__host__ __device__ __forceinline__ int lds_byte(int r, int c) { const int st = (r >> 4) * 2 + (c >> 5), rr = r & 15, cc = c & 31, ob = rr * 64 + cc * 2; return st * 1024 + (ob ^ (((ob >> 9) & 1) << 5)); }
__host__ __device__ __forceinline__ void stage_rc(int b, int& R, int& C) { const int st = b / 1024, sb = b % 1024, swz = sb ^ (((sb >> 9) & 1) << 5); R = (st >> 1) * 16 + swz / 64; C = (st & 1) * 32 + (swz % 64) / 2; }
__host__ __device__ __forceinline__ int perm32(int rho) { const int n = rho >> 4, i = rho & 15; return 8 * (i >> 2) + 4 * n + (i & 3); }
__device__ __forceinline__ unsigned cvt_pk_bf16(float lo, float hi) { unsigned r; asm volatile("v_cvt_pk_bf16_f32 %0, %1, %2" : "=v"(r) : "v"(lo), "v"(hi)); return r; }

struct Unit { const char* a; const char* b; int pm, pn; };

template <class Epi, class Sched>
__device__ __forceinline__ void gemm_phase(G8_LAS unsigned char* lds, const int lda, const int ldb, const int K, const Sched& S, const Epi& E) {
    const int tid = threadIdx.x, wid = __builtin_amdgcn_readfirstlane(tid >> 6), lane = tid & 63, wr = wid >> 2, wc = wid & 3, fr = lane & 15, fq = lane >> 4;
    const int nt = K / BK;
    unsigned voffA[2], voffB[2];
#pragma unroll
    for (int i = 0; i < 2; ++i) { int R, C; stage_rc(tid * 16 + i * 8192, R, C); const int Rb = (R & ~31) + perm32(R & 31);
        voffA[i] = (unsigned)(R * lda + C * 2); voffB[i] = (unsigned)(Rb * ldb + C * 2); }
    const size_t kstep = (size_t)(BK * 2);
    const size_t hstepA = (size_t)HALF * lda, hstepB = (size_t)HALF * ldb;
    const unsigned ldsw = (unsigned)wid * 1024u;
    const int aoff = lds_byte(wr * 64 + fr, fq * 8), boff = lds_byte(wc * 32 + fr, fq * 8);
#define G8_SA(b, h) (((b) * 2 + (h)) * HTB)
#define G8_SB(b, h) ((4 + (b) * 2 + (h)) * HTB)
#define G8_STAGE(bufoff, gbase, voff) do { _Pragma("unroll") for (int _i = 0; _i < 2; ++_i) \
        __builtin_amdgcn_global_load_lds((const unsigned*)((const char*)(gbase) + (voff)[_i]), (G8_LAS unsigned*)(lds + (bufoff) + ldsw + _i * 8192), 16, 0, 0); } while (0)
#define G8_LDA(dst, b, h) do { _Pragma("unroll") for (int m = 0; m < 4; ++m) _Pragma("unroll") for (int k = 0; k < 2; ++k) dst[m][k] = *(const G8_LAS bf16x8*)(lds + G8_SA(b, h) + aoff + m * 2048 + k * 1024); } while (0)
#define G8_LDB(dst, b, h) do { _Pragma("unroll") for (int n = 0; n < 2; ++n) _Pragma("unroll") for (int k = 0; k < 2; ++k) dst[n][k] = *(const G8_LAS bf16x8*)(lds + G8_SB(b, h) + boff + n * 2048 + k * 1024); } while (0)
#define G8_MMA(ai, bj, At, Bt) do { __builtin_amdgcn_s_setprio(1); _Pragma("unroll") for (int m = 0; m < 4; ++m) _Pragma("unroll") for (int n = 0; n < 2; ++n) _Pragma("unroll") for (int k = 0; k < 2; ++k) \
        acc[ai][bj][m][n] = __builtin_amdgcn_mfma_f32_16x16x32_bf16(Bt[n][k], At[m][k], acc[ai][bj][m][n], 0, 0, 0); __builtin_amdgcn_s_setprio(0); } while (0)
#define G8_WAIT_V(n) asm volatile("s_waitcnt vmcnt(" #n ")" ::: "memory")
#define G8_WAIT_L(n) asm volatile("s_waitcnt lgkmcnt(" #n ")" ::: "memory")
#define G8_BAR __builtin_amdgcn_s_barrier()
#define G8_SCHED __builtin_amdgcn_sched_barrier(0)
    Unit cur, nxt; int ui = 0;
    if (!S.next(0, cur)) return;
    f32x4 acc[2][2][4][2];
#pragma unroll
    for (int a = 0; a < 2; ++a)
#pragma unroll
        for (int b = 0; b < 2; ++b)
#pragma unroll
            for (int m = 0; m < 4; ++m)
#pragma unroll
                for (int n = 0; n < 2; ++n) acc[a][b][m][n] = (f32x4){0.f, 0.f, 0.f, 0.f};
    bf16x8 At[4][2], B0[2][2], B1[2][2];
    const char* cA = cur.a; const char* cB = cur.b;
    G8_STAGE(G8_SB(0, 0), cB, voffB); G8_STAGE(G8_SA(0, 0), cA, voffA); G8_STAGE(G8_SB(0, 1), cB + hstepB, voffB); G8_STAGE(G8_SA(0, 1), cA + hstepA, voffA);
    if (wr == 1) G8_BAR;
    G8_WAIT_V(4); G8_BAR;
    G8_STAGE(G8_SB(1, 0), cB + kstep, voffB); G8_STAGE(G8_SA(1, 0), cA + kstep, voffA); G8_STAGE(G8_SB(1, 1), cB + hstepB + kstep, voffB);
    G8_WAIT_V(6); G8_BAR;
    for (;;) {
        const bool has_next = S.next(ui + 1, nxt);
        const char* nA = has_next ? nxt.a : cA; const char* nB = has_next ? nxt.b : cB;
        for (int t = 0; t < nt; t += 2) {
            const bool last = (t == nt - 2);
            const char* a1 = cA + (size_t)(t + 1) * kstep;
            const char* a2 = last ? nA : cA + (size_t)(t + 2) * kstep; const char* b2 = last ? nB : cB + (size_t)(t + 2) * kstep;
            const char* a3 = a2 + kstep; const char* b3 = b2 + kstep;
            G8_LDB(B0, 0, 0); G8_SCHED; G8_LDA(At, 0, 0); G8_STAGE(G8_SA(1, 1), a1 + hstepA, voffA);
            G8_WAIT_L(8); G8_BAR; G8_WAIT_L(0); G8_MMA(0, 0, At, B0); G8_BAR; G8_SCHED;
            G8_LDB(B1, 0, 1); G8_STAGE(G8_SB(0, 0), b2, voffB);
            G8_BAR; G8_WAIT_L(0); G8_MMA(0, 1, At, B1); G8_BAR;
            G8_LDA(At, 0, 1); G8_STAGE(G8_SA(0, 0), a2, voffA);
            G8_BAR; G8_WAIT_L(0); G8_MMA(1, 0, At, B0); G8_BAR; G8_SCHED;
            G8_STAGE(G8_SB(0, 1), b2 + hstepB, voffB);
            G8_WAIT_V(6); G8_BAR; G8_MMA(1, 1, At, B1); G8_BAR;
            G8_LDB(B0, 1, 0); G8_SCHED; G8_LDA(At, 1, 0); G8_STAGE(G8_SA(0, 1), a2 + hstepA, voffA);
            G8_WAIT_L(8); G8_BAR; G8_WAIT_L(0); G8_MMA(0, 0, At, B0); G8_BAR; G8_SCHED;
            G8_LDB(B1, 1, 1); G8_STAGE(G8_SB(1, 0), b3, voffB);
            G8_BAR; G8_WAIT_L(0); G8_MMA(0, 1, At, B1); G8_BAR;
            G8_LDA(At, 1, 1); G8_STAGE(G8_SA(1, 0), a3, voffA);
            G8_BAR; G8_WAIT_L(0); G8_MMA(1, 0, At, B0); G8_BAR; G8_SCHED;
            G8_STAGE(G8_SB(1, 1), b3 + hstepB, voffB);
            G8_WAIT_V(6); G8_BAR; G8_MMA(1, 1, At, B1); G8_BAR;
        }
        E(acc, cur, wr, wc, fr, fq);
        if (!has_next) break;
#pragma unroll
        for (int a = 0; a < 2; ++a)
#pragma unroll
            for (int b = 0; b < 2; ++b)
#pragma unroll
                for (int m = 0; m < 4; ++m)
#pragma unroll
                    for (int n = 0; n < 2; ++n) acc[a][b][m][n] = (f32x4){0.f, 0.f, 0.f, 0.f};
        cur = nxt; cA = nA; cB = nB; ++ui;
    }
    G8_WAIT_V(0);
    if (wr == 0) G8_BAR;
    G8_BAR;
#undef G8_SA
#undef G8_SB
#undef G8_STAGE
#undef G8_LDA
#undef G8_LDB
#undef G8_MMA
#undef G8_WAIT_V
#undef G8_WAIT_L
#undef G8_BAR
#undef G8_SCHED
}


struct DenseOrder {
    const char* A; const char* B; int lda, ldb, nM, nN, G, c;
    __device__ __forceinline__ bool next(int i, Unit& u) const {
        const int L = i * G + c; if (L >= nM * nN) return false;
        const int grp = L / (8 * nN), rem = L % (8 * nN); const int gsz = (nM - grp * 8) < 8 ? (nM - grp * 8) : 8;
        u.pm = grp * 8 + rem % gsz; u.pn = rem / gsz;
        u.a = A + (size_t)u.pm * BM * lda; u.b = B + (size_t)u.pn * BM * ldb; return true;
    }
};

struct EpiGroups {
    bf16_t* dst; const float* rs; int upg; int ld; size_t gstride;
    __device__ __forceinline__ void operator()(const f32x4 (&acc)[2][2][4][2], const Unit& u, int wr, int wc, int fr, int fq) const {
        const int row0 = u.pm * BM + wr * 64 + fr;
        bf16_t* base = dst + (size_t)(u.pn / upg) * gstride + (u.pn % upg) * 256 + wc * 32 + 8 * fq;
#pragma unroll
        for (int ai = 0; ai < 2; ++ai)
#pragma unroll
            for (int m = 0; m < 4; ++m) { const int row = row0 + ai * HALF + m * 16; const float sc = rs[row]; bf16_t* rowp = base + (size_t)row * ld;
#pragma unroll
                for (int bj = 0; bj < 2; ++bj) { const f32x4 v0 = acc[ai][bj][m][0] * sc, v1 = acc[ai][bj][m][1] * sc;
                    u32x4 w; w.x = cvt_pk_bf16(v0[0], v0[1]); w.y = cvt_pk_bf16(v0[2], v0[3]); w.z = cvt_pk_bf16(v1[0], v1[1]); w.w = cvt_pk_bf16(v1[2], v1[3]);
                    *(u32x4*)(rowp + bj * HALF) = w; } }
    }
};
struct EpiOdd {
    bf16_t* pq; bf16_t* pk; bf16_t* pv; bf16_t* pg; const float* rs;
    __device__ __forceinline__ void operator()(const f32x4 (&acc)[2][2][4][2], const Unit& u, int wr, int wc, int fr, int fq) const {
        const int row0 = u.pm * BM + wr * 64 + fr;
        bf16_t* base; int ld, ct;
        if (u.pn < 4) { base = pq; ld = 1024; ct = u.pn; } else if (u.pn < 8) { base = pk; ld = 1024; ct = u.pn - 4; }
        else if (u.pn < 16) { base = pv; ld = 2048; ct = u.pn - 8; } else { base = pg; ld = 2048; ct = u.pn - 16; }
        base += ct * 256 + wc * 32 + 8 * fq;
#pragma unroll
        for (int ai = 0; ai < 2; ++ai)
#pragma unroll
            for (int m = 0; m < 4; ++m) { const int row = row0 + ai * HALF + m * 16; const float sc = rs[row]; bf16_t* rowp = base + (size_t)row * ld;
#pragma unroll
                for (int bj = 0; bj < 2; ++bj) { const f32x4 v0 = acc[ai][bj][m][0] * sc, v1 = acc[ai][bj][m][1] * sc;
                    u32x4 w; w.x = cvt_pk_bf16(v0[0], v0[1]); w.y = cvt_pk_bf16(v0[2], v0[3]); w.z = cvt_pk_bf16(v1[0], v1[1]); w.w = cvt_pk_bf16(v1[2], v1[3]);
                    *(u32x4*)(rowp + bj * HALF) = w; } }
    }
};
struct EpiRes {
    const float* xin; float* xout; bf16_t* xb;
    __device__ __forceinline__ void operator()(const f32x4 (&acc)[2][2][4][2], const Unit& u, int wr, int wc, int fr, int fq) const {
        const int row0 = u.pm * BM + wr * 64 + fr; const int col0 = u.pn * BM + wc * 32 + 8 * fq;
#pragma unroll
        for (int ai = 0; ai < 2; ++ai)
#pragma unroll
            for (int m = 0; m < 4; ++m) { const size_t ro = (size_t)(row0 + ai * HALF + m * 16) * 1024 + col0;
#pragma unroll
                for (int bj = 0; bj < 2; ++bj) {
                    const f32x4 r0 = *(const f32x4*)(xin + ro + bj * HALF), r1 = *(const f32x4*)(xin + ro + bj * HALF + 4);
                    const f32x4 v0 = acc[ai][bj][m][0] + r0, v1 = acc[ai][bj][m][1] + r1;
                    *(f32x4*)(xout + ro + bj * HALF) = v0; *(f32x4*)(xout + ro + bj * HALF + 4) = v1;
                    u32x4 w; w.x = cvt_pk_bf16(v0[0], v0[1]); w.y = cvt_pk_bf16(v0[2], v0[3]); w.z = cvt_pk_bf16(v1[0], v1[1]); w.w = cvt_pk_bf16(v1[2], v1[3]);
                    *(u32x4*)(xb + ro + bj * HALF) = w; } }
    }
};
}
typedef g8::bf16_t bf16_t;
typedef g8::u32x4 u32x4;
typedef g8::u32x2 u32x2;
#define LAS __attribute__((address_space(3)))

constexpr size_t MiB = (size_t)1 << 20;
constexpr size_t WS_RS = 64 * 1024;
constexpr size_t WS_GATES = 128 * 1024;
constexpr size_t WS_XB = 4 * MiB;
constexpr size_t WS_WIN0 = 36 * MiB;
constexpr size_t WS_WOUT0 = 44 * MiB;
constexpr size_t WS_WIN1 = 46 * MiB;
constexpr size_t WS_WOUT1 = 58 * MiB;
constexpr size_t WS_P = 62 * MiB;
constexpr size_t GRP0 = 16 * MiB;
constexpr size_t WS_O0 = WS_P + 8 * GRP0;
constexpr size_t WS_PQ = WS_P, WS_PK = WS_P + 32 * MiB, WS_PV = WS_P + 64 * MiB, WS_PG = WS_P + 128 * MiB;
constexpr size_t WS_END = WS_P + 192 * MiB;
constexpr int LDS_BYTES = g8::STAGE_BYTES;

struct Args { const float* in[21]; float* out; unsigned char* ws; };

__device__ __forceinline__ void conv_tile(const float* __restrict__ W, int ldw, int srccol0, const float* __restrict__ scale, bf16_t* __restrict__ Wt, int K, int k0, int n0, LAS float* tile) {
    const int t = threadIdx.x;
    for (int i = t; i < 64 * 64; i += NTHREADS) { const int kk = i >> 6, nn = i & 63; float v = W[(size_t)(k0 + kk) * ldw + srccol0 + nn]; if (scale) v *= scale[k0 + kk]; tile[kk * 65 + nn] = v; }
    __syncthreads();
    { const int nn = t >> 3, kc = t & 7;
      u32x4 o; o.x = g8::cvt_pk_bf16(tile[(kc * 8 + 0) * 65 + nn], tile[(kc * 8 + 1) * 65 + nn]); o.y = g8::cvt_pk_bf16(tile[(kc * 8 + 2) * 65 + nn], tile[(kc * 8 + 3) * 65 + nn]);
      o.z = g8::cvt_pk_bf16(tile[(kc * 8 + 4) * 65 + nn], tile[(kc * 8 + 5) * 65 + nn]); o.w = g8::cvt_pk_bf16(tile[(kc * 8 + 6) * 65 + nn], tile[(kc * 8 + 7) * 65 + nn]);
      *(u32x4*)(Wt + (size_t)(n0 + nn) * K + k0 + kc * 8) = o; }
    __syncthreads();
}

__device__ __forceinline__ void phase_prep(const Args& a, LAS unsigned char* lds) {
    const float* x = a.in[0]; const float* nmw = a.in[1];
    const float* w_in0 = a.in[3]; const float* a_log = a.in[5]; const float* dt_bias = a.in[6];
    unsigned char* ws = a.ws;
    LAS float* Wg8 = (LAS float*)lds;
    LAS float* tile = (LAS float*)(lds + 32768);
    const int tid = threadIdx.x, lane = tid & 63, wave = tid >> 6;
    for (int i = tid; i < 1024 * 8; i += NTHREADS) { const int k = i >> 3, j = i & 7; Wg8[i] = w_in0[(size_t)k * EVEN_IN + 2048 + j] * nmw[k]; }
    __syncthreads();
    float* RS = (float*)(ws + WS_RS); float* GATES = (float*)(ws + WS_GATES); bf16_t* XB = (bf16_t*)(ws + WS_XB);
    for (int m = blockIdx.x * NWAVES + wave; m < NTOK; m += gridDim.x * NWAVES) {
        const float4* xr = (const float4*)(x + (size_t)m * D_MODEL) + lane;
        float4 v[4]; float s = 0.f;
#pragma unroll
        for (int j = 0; j < 4; ++j) { v[j] = xr[64 * j]; s += v[j].x * v[j].x + v[j].y * v[j].y + v[j].z * v[j].z + v[j].w * v[j].w; }
        s = wave_sum(s);
        const float rs = rsqrtf(s * (1.0f / D_MODEL) + 1e-6f);
        float g[8];
#pragma unroll
        for (int q = 0; q < 8; ++q) g[q] = 0.f;
#pragma unroll
        for (int j = 0; j < 4; ++j) {
            const float xv[4] = {v[j].x, v[j].y, v[j].z, v[j].w};
#pragma unroll
            for (int e = 0; e < 4; ++e) { const int k = 256 * j + 4 * lane + e;
#pragma unroll
                for (int q = 0; q < 8; ++q) g[q] = fmaf(xv[e], Wg8[k * 8 + q], g[q]); }
            u32x2 o; o.x = g8::cvt_pk_bf16(v[j].x, v[j].y); o.y = g8::cvt_pk_bf16(v[j].z, v[j].w);
            *((u32x2*)(XB + (size_t)m * D_MODEL) + lane + 64 * j) = o;
        }
#pragma unroll
        for (int q = 0; q < 8; ++q) g[q] = wave_sum(g[q]) * rs;
        if (lane == 0) {
            RS[m] = rs;
#pragma unroll
            for (int h = 0; h < 4; ++h) { GATES[(size_t)m * 8 + h] = sigmoidf_(g[h]); GATES[(size_t)m * 8 + 4 + h] = -__expf(a_log[h]) * softplusf_(g[4 + h] + dt_bias[h]); }
        }
    }
    constexpr int I0 = 16 * 64, I1 = 16 * 16, I2 = 16 * 96, I3 = 32 * 16;
    for (int it = blockIdx.x; it < I0 + I1 + I2 + I3; it += gridDim.x) {
        int r = it;
        if (r < I0) { const int k0 = (r / 64) * 64, n0 = (r % 64) * 64; conv_tile(w_in0, EVEN_IN, n0 + (n0 >= 2048 ? 8 : 0), nmw, (bf16_t*)(ws + WS_WIN0), 1024, k0, n0, tile); continue; } r -= I0;
        if (r < I1) { const int k0 = (r / 16) * 64, n0 = (r % 16) * 64; conv_tile(a.in[10], 1024, n0, nullptr, (bf16_t*)(ws + WS_WOUT0), 1024, k0, n0, tile); continue; } r -= I1;
        if (r < I2) { const int k0 = (r / 96) * 64, n0 = (r % 96) * 64; conv_tile(a.in[11], ODD_IN, n0, nmw + 1024, (bf16_t*)(ws + WS_WIN1), 1024, k0, n0, tile); continue; } r -= I2;
        { const int k0 = (r / 16) * 64, n0 = (r % 16) * 64; conv_tile(a.in[13], 1024, n0, nullptr, (bf16_t*)(ws + WS_WOUT1), 2048, k0, n0, tile); }
    }
}

__device__ __forceinline__ void phase_mix0_simple(const Args& a, LAS unsigned char* lds) {
    unsigned char* ws = a.ws;
    const int item = blockIdx.x; if (item >= 32) return;
    const int c = threadIdx.x; const bool act = c < 128; const int cc = c & 127;
    const int bh = item & 15, b = bh >> 2, h = bh & 3;
    LAS float* qs = (LAS float*)lds; LAS float* ks = qs + 128; LAS float* fs = ks + 128; LAS float* red = fs + 128;
    bf16_t* O = (bf16_t*)(ws + WS_O0);
    const float scale = 0.08838834764831845f;
    if (item < 16) {
        const bool act2 = c < 256; const int half = (c >> 7) & 1;
        LAS float* red2 = red + 8;
        float S[64];
#pragma unroll
        for (int i = 0; i < 64; ++i) S[i] = 0.f;
        const bf16_t* Gq = (const bf16_t*)(ws + WS_P); const bf16_t* Gk = (const bf16_t*)(ws + WS_P + GRP0); const bf16_t* Gv = (const bf16_t*)(ws + WS_P + 2 * GRP0);
        const float* GATES = (const float*)(ws + WS_GATES); const float* cw = a.in[4];
        float wq[4], wk[4], wv[4];
#pragma unroll
        for (int j = 0; j < 4; ++j) { wq[j] = cw[j * 1536 + h * 128 + cc]; wk[j] = cw[j * 1536 + 512 + h * 128 + cc]; wv[j] = cw[j * 1536 + 1024 + h * 128 + cc]; }
        float hq0 = 0.f, hq1 = 0.f, hq2 = 0.f, hk0 = 0.f, hk1 = 0.f, hk2 = 0.f, hv0 = 0.f, hv1 = 0.f, hv2 = 0.f;
        for (int t = 0; t < SEQ; ++t) {
            const size_t tok = (size_t)b * SEQ + t;
            float q = 0.f, k = 0.f, v = 0.f;
            if (act2) {
                const float xq = bf2f(Gq[tok * 512 + h * 128 + cc]), xk = bf2f(Gk[tok * 512 + h * 128 + cc]), xv = bf2f(Gv[tok * 512 + h * 128 + cc]);
                q = siluf_(hq0 * wq[0] + hq1 * wq[1] + hq2 * wq[2] + xq * wq[3]); hq0 = hq1; hq1 = hq2; hq2 = xq;
                k = siluf_(hk0 * wk[0] + hk1 * wk[1] + hk2 * wk[2] + xk * wk[3]); hk0 = hk1; hk1 = hk2; hk2 = xk;
                v = siluf_(hv0 * wv[0] + hv1 * wv[1] + hv2 * wv[2] + xv * wv[3]); hv0 = hv1; hv1 = hv2; hv2 = xv;
                const float sq = wave_sum(q * q), sk = wave_sum(k * k);
                if (c < 128 && (c & 63) == 0) { red[(c >> 6) * 2] = sq; red[(c >> 6) * 2 + 1] = sk; }
            }
            __syncthreads();
            if (act) { qs[cc] = q * rsqrtf(red[0] + red[2] + 1e-6f); ks[cc] = k * rsqrtf(red[1] + red[3] + 1e-6f); }
            __syncthreads();
            float be = 0.f, aa = 0.f;
            if (act2) {
                be = GATES[tok * 8 + h]; aa = __expf(GATES[tok * 8 + 4 + h]);
                float kd = 0.f;
#pragma unroll
                for (int i = 0; i < 64; ++i) { S[i] *= aa; kd = fmaf(ks[half * 64 + i], S[i], kd); }
                red2[c] = kd;
            }
            __syncthreads();
            float oo = 0.f;
            if (act2) {
                const float r = be * (v - (red2[cc] + red2[128 + cc]));
#pragma unroll
                for (int i = 0; i < 64; ++i) { S[i] = fmaf(ks[half * 64 + i], r, S[i]); oo = fmaf(qs[half * 64 + i], S[i], oo); }
            }
            __syncthreads();
            if (act2 && half == 1) red2[cc] = oo;
            __syncthreads();
            if (act) O[tok * 1024 + h * 128 + cc] = (bf16_t)(g8::cvt_pk_bf16((oo + red2[cc]) * scale, 0.f) & 0xffffu);
        }
    } else {
        const bf16_t* Hq = (const bf16_t*)(ws + WS_P + 4 * GRP0); const bf16_t* Hf = (const bf16_t*)(ws + WS_P + 5 * GRP0); const bf16_t* Hi = (const bf16_t*)(ws + WS_P + 6 * GRP0);
        const float* lbl = a.in[8];
        float S[128];
#pragma unroll
        for (int i = 0; i < 128; ++i) S[i] = 0.f;
        float lb;
        { const int ch = h * 128 + cc; const float l0 = lbl[ch], l1 = lbl[512 + ch], l2 = lbl[1024 + ch]; const float mx = fmaxf(l0, fmaxf(l1, l2));
          const float e0 = __expf(l0 - mx), e1 = __expf(l1 - mx), e2 = __expf(l2 - mx); lb = e0 / (e0 + e1 + e2); }
        for (int t = 0; t < SEQ; ++t) {
            const size_t tok = (size_t)b * SEQ + t;
            float iv = 0.f;
            if (act) {
                const float xq = bf2f(Hq[tok * 512 + h * 128 + cc]), xf = bf2f(Hf[tok * 512 + h * 128 + cc]); iv = bf2f(Hi[tok * 512 + h * 128 + cc]);
                const float f = lb + (1.f - lb) * sigmoidf_(xf);
                qs[cc] = siluf_(xq); fs[cc] = f; ks[cc] = 1.f - f;
            }
            __syncthreads();
            if (act) {
                float oo = 0.f;
#pragma unroll
                for (int i0 = 0; i0 < 128; i0 += 16) {
#pragma unroll
                    for (int i = i0; i < i0 + 16; ++i) { S[i] = fmaf(fs[i], S[i], ks[i] * iv); oo = fmaf(qs[i], S[i], oo); }
                    asm volatile("" ::: "memory"); }
                O[tok * 1024 + 512 + h * 128 + cc] = (bf16_t)(g8::cvt_pk_bf16(oo * scale, 0.f) & 0xffffu);
            }
            __syncthreads();
        }
    }
}

__device__ __forceinline__ void phase_post0(const Args& a) {
    unsigned char* ws = a.ws;
    bf16_t* O = (bf16_t*)(ws + WS_O0);
    const bf16_t* Gz = (const bf16_t*)(ws + WS_P + 3 * GRP0); const bf16_t* Hg = (const bf16_t*)(ws + WS_P + 7 * GRP0);
    const float* gnw = a.in[7]; const float* hnw = a.in[9];
    const int lane = threadIdx.x & 63, wave = threadIdx.x >> 6;
    const int hd = lane >> 3;
    const float* nw = hd < 4 ? gnw : hnw;
    for (int m = blockIdx.x * NWAVES + wave; m < NTOK; m += gridDim.x * NWAVES) {
        const u32x4* op = (const u32x4*)(O + (size_t)m * 1024 + 16 * lane);
        const bf16_t* zsrc = hd < 4 ? Gz + (size_t)m * 512 + 16 * lane : Hg + (size_t)m * 512 + 16 * lane - 512;
        const u32x4 o0 = op[0], o1 = op[1]; const u32x4 z0 = ((const u32x4*)zsrc)[0], z1 = ((const u32x4*)zsrc)[1];
        const unsigned ow[8] = {o0.x, o0.y, o0.z, o0.w, o1.x, o1.y, o1.z, o1.w}; const unsigned zw[8] = {z0.x, z0.y, z0.z, z0.w, z1.x, z1.y, z1.z, z1.w};
        float v[16], z[16]; float s = 0.f;
#pragma unroll
        for (int i = 0; i < 8; ++i) { v[2 * i] = __uint_as_float(ow[i] << 16); v[2 * i + 1] = __uint_as_float(ow[i] & 0xffff0000u); z[2 * i] = __uint_as_float(zw[i] << 16); z[2 * i + 1] = __uint_as_float(zw[i] & 0xffff0000u); }
#pragma unroll
        for (int i = 0; i < 16; ++i) s += v[i] * v[i];
        s += __shfl_xor(s, 1); s += __shfl_xor(s, 2); s += __shfl_xor(s, 4);
        const float rs = rsqrtf(s * (1.f / 128.f) + 1e-6f);
        unsigned r[8];
#pragma unroll
        for (int i = 0; i < 8; ++i) { const int c0 = (16 * lane + 2 * i) & 127;
            r[i] = g8::cvt_pk_bf16(v[2 * i] * rs * nw[c0] * siluf_(z[2 * i]), v[2 * i + 1] * rs * nw[c0 + 1] * siluf_(z[2 * i + 1])); }
        u32x4* wp = (u32x4*)(O + (size_t)m * 1024 + 16 * lane);
        wp[0] = (u32x4){r[0], r[1], r[2], r[3]}; wp[1] = (u32x4){r[4], r[5], r[6], r[7]};
    }
}

template <bool FINAL>
__device__ __forceinline__ void phase_moe_simple(const Args& a, int layer, LAS unsigned char* lds) {
    unsigned char* ws = a.ws;
    float* xio = a.out;
    const float* nw = a.in[2] + layer * 1024; const float* wc = a.in[14] + layer * 1024 * 4; const float* bc = a.in[15] + layer * 4;
    const float* wf = a.in[16] + layer * 1024 * 16; const float* bfp = a.in[17] + layer * 16;
    const float* wgu = a.in[18] + (size_t)layer * 16 * 1024 * 512; const float* wd = a.in[19] + (size_t)layer * 16 * 256 * 1024;
    const float* fw = a.in[20];
    bf16_t* XB = (bf16_t*)(ws + WS_XB); float* RS = (float*)(ws + WS_RS);
    LAS float* hs = (LAS float*)lds; LAS float* gu = hs + 1024; LAS float* actv = gu + 512; LAS float* red = actv + 256; LAS float* logits = red + 16; LAS float* selw = logits + 32; LAS int* sele = (LAS int*)(selw + 4);
    const int t = threadIdx.x;
    for (int tok = blockIdx.x; tok < NTOK; tok += gridDim.x) {
        float xv0 = xio[(size_t)tok * 1024 + t], xv1 = xio[(size_t)tok * 1024 + 512 + t];
        float s = wave_sum(xv0 * xv0 + xv1 * xv1);
        __syncthreads();
        if ((t & 63) == 0) red[t >> 6] = s;
        __syncthreads();
        s = 0.f;
#pragma unroll
        for (int i = 0; i < 8; ++i) s += red[i];
        const float rs = rsqrtf(s * (1.0f / D_MODEL) + 1e-6f);
        hs[t] = xv0 * rs * nw[t]; hs[512 + t] = xv1 * rs * nw[512 + t];
        __syncthreads();
        if (t < 20) {
            float acc = 0.f;
            if (t < 4) { for (int k = 0; k < 1024; ++k) acc = fmaf(hs[k], wc[k * 4 + t], acc); acc += bc[t]; }
            else { const int e = t - 4; for (int k = 0; k < 1024; ++k) acc = fmaf(hs[k], wf[k * 16 + e], acc); acc += bfp[e]; }
            logits[t] = acc;
        }
        __syncthreads();
        if (t == 0) {
            float mx = logits[0]; int gi = 0;
            for (int i = 1; i < 4; ++i) if (logits[i] > mx) { mx = logits[i]; gi = i; }
            float den = 0.f;
            for (int i = 0; i < 4; ++i) den += __expf(logits[i] - mx);
            const float gprob = 1.f / den;
            float f0 = logits[4 + gi * 4], f1 = logits[5 + gi * 4], f2 = logits[6 + gi * 4], f3 = logits[7 + gi * 4];
            const float fl[4] = {f0, f1, f2, f3};
            int e0 = 0; float m0 = fl[0];
            for (int i = 1; i < 4; ++i) if (fl[i] > m0) { m0 = fl[i]; e0 = i; }
            int e1 = -1; float m1 = -3.0e38f;
            for (int i = 0; i < 4; ++i) if (i != e0 && fl[i] > m1) { m1 = fl[i]; e1 = i; }
            const float p1 = __expf(m1 - m0);
            sele[0] = gi * 4 + e0; sele[1] = gi * 4 + e1;
            selw[0] = gprob / (1.f + p1); selw[1] = gprob * p1 / (1.f + p1);
        }
        __syncthreads();
        float o0 = 0.f, o1 = 0.f;
        for (int s2 = 0; s2 < 2; ++s2) {
            const int e = sele[s2]; const float gw = selw[s2];
            const float* W = wgu + (size_t)e * 1024 * 512;
            float g = 0.f;
            for (int k = 0; k < 1024; ++k) g = fmaf(hs[k], W[(size_t)k * 512 + t], g);
            gu[t] = g;
            __syncthreads();
            if (t < 256) actv[t] = siluf_(gu[t]) * gu[256 + t] * gw;
            __syncthreads();
            const float* Wd = wd + (size_t)e * 256 * 1024;
            for (int f = 0; f < 256; ++f) { const float av = actv[f]; o0 = fmaf(av, Wd[(size_t)f * 1024 + t], o0); o1 = fmaf(av, Wd[(size_t)f * 1024 + 512 + t], o1); }
        }
        xv0 += o0; xv1 += o1;
        float s3 = wave_sum(xv0 * xv0 + xv1 * xv1);
        __syncthreads();
        if ((t & 63) == 0) red[t >> 6] = s3;
        __syncthreads();
        s3 = 0.f;
#pragma unroll
        for (int i = 0; i < 8; ++i) s3 += red[i];
        const float rs2 = rsqrtf(s3 * (1.0f / D_MODEL) + 1e-6f);
        if (FINAL) { xio[(size_t)tok * 1024 + t] = xv0 * rs2 * fw[t]; xio[(size_t)tok * 1024 + 512 + t] = xv1 * rs2 * fw[512 + t]; }
        else {
            xio[(size_t)tok * 1024 + t] = xv0; xio[(size_t)tok * 1024 + 512 + t] = xv1;
            XB[(size_t)tok * 1024 + t] = (bf16_t)(g8::cvt_pk_bf16(xv0, 0.f) & 0xffffu); XB[(size_t)tok * 1024 + 512 + t] = (bf16_t)(g8::cvt_pk_bf16(xv1, 0.f) & 0xffffu);
            if (t == 0) RS[tok] = rs2;
        }
    }
}

__device__ __forceinline__ void phase_ret_simple(const Args& a, LAS unsigned char* lds) {
    unsigned char* ws = a.ws;
    const int item = blockIdx.x; if (item >= 32) return;
    const int bh = item >> 1, cgp = item & 1, b = bh >> 2, h = bh & 3;
    const int t = threadIdx.x, half = t >> 8, cl = t & 255, col = cgp * 256 + cl;
    const bf16_t* Pq = (const bf16_t*)(ws + WS_PQ); const bf16_t* Pk = (const bf16_t*)(ws + WS_PK); bf16_t* Pv = (bf16_t*)(ws + WS_PV);
    LAS float* qk = (LAS float*)lds;
    LAS float* red = qk + 512;
    const float gamma = 1.0f - exp2f(-5.0f - (float)h);
    const int e = t & 255, p = e >> 1, odd = e & 1;
    const float inv = 1.0f / powf(10000.0f, (float)p / 127.0f);
    const bf16_t* src = (t < 256 ? Pq : Pk) + h * 256 + 2 * p;
    const float osc = t < 256 ? 1.0f : 0.0625f;
    float S[128];
#pragma unroll
    for (int i = 0; i < 128; ++i) S[i] = 0.f;
    for (int tt = 0; tt < SEQ; ++tt) {
        const size_t tok = (size_t)b * SEQ + tt;
        { const unsigned w = *(const unsigned*)(src + tok * 1024); const float x1 = __uint_as_float(w << 16), x2 = __uint_as_float(w & 0xffff0000u);
          float sn, cs; sincosf((float)tt * inv, &sn, &cs);
          qk[t] = (odd ? (x1 * sn + x2 * cs) : (x1 * cs - x2 * sn)) * osc; }
        const float v = bf2f(Pv[tok * 2048 + h * 512 + col]);
        __syncthreads();
        float oo = 0.f;
#pragma unroll
        for (int i0 = 0; i0 < 128; i0 += 16) {
#pragma unroll
            for (int i = i0; i < i0 + 16; ++i) { S[i] = fmaf(gamma, S[i], qk[256 + half * 128 + i] * v); oo = fmaf(qk[half * 128 + i], S[i], oo); }
            asm volatile("" ::: "memory"); }
        if (half == 1) red[cl] = oo;
        __syncthreads();
        if (half == 0) Pv[tok * 2048 + h * 512 + col] = (bf16_t)(g8::cvt_pk_bf16(oo + red[cl], 0.f) & 0xffffu);
    }
}

__device__ __forceinline__ void phase_post1(const Args& a) {
    unsigned char* ws = a.ws;
    bf16_t* O = (bf16_t*)(ws + WS_PV); const bf16_t* G = (const bf16_t*)(ws + WS_PG);
    const float* nw = a.in[12];
    const int lane = threadIdx.x & 63, wave = threadIdx.x >> 6;
    for (int m = blockIdx.x * NWAVES + wave; m < NTOK; m += gridDim.x * NWAVES) {
        float v[32], z[32]; float s = 0.f;
#pragma unroll
        for (int q = 0; q < 4; ++q) {
            const u32x4 o = *((const u32x4*)(O + (size_t)m * 2048 + 32 * lane) + q); const u32x4 zz = *((const u32x4*)(G + (size_t)m * 2048 + 32 * lane) + q);
            const unsigned ow[4] = {o.x, o.y, o.z, o.w}; const unsigned zw[4] = {zz.x, zz.y, zz.z, zz.w};
#pragma unroll
            for (int i = 0; i < 4; ++i) { v[8 * q + 2 * i] = __uint_as_float(ow[i] << 16); v[8 * q + 2 * i + 1] = __uint_as_float(ow[i] & 0xffff0000u);
                z[8 * q + 2 * i] = __uint_as_float(zw[i] << 16); z[8 * q + 2 * i + 1] = __uint_as_float(zw[i] & 0xffff0000u); }
        }
#pragma unroll
        for (int i = 0; i < 32; ++i) s += v[i] * v[i];
        s += __shfl_xor(s, 1); s += __shfl_xor(s, 2); s += __shfl_xor(s, 4); s += __shfl_xor(s, 8);
        const float rs = rsqrtf(s * (1.f / 512.f) + 1e-6f);
#pragma unroll
        for (int q = 0; q < 4; ++q) {
            unsigned r[4];
#pragma unroll
            for (int i = 0; i < 4; ++i) { const int j = 8 * q + 2 * i; const int c0 = (32 * lane + j) & 511;
                r[i] = g8::cvt_pk_bf16(v[j] * rs * nw[c0] * siluf_(z[j]), v[j + 1] * rs * nw[c0 + 1] * siluf_(z[j + 1])); }
            *((u32x4*)(O + (size_t)m * 2048 + 32 * lane) + q) = (u32x4){r[0], r[1], r[2], r[3]};
        }
    }
}

__global__ void __launch_bounds__(NTHREADS, 2) mega(Args a) {
    extern __shared__ __attribute__((aligned(16))) unsigned char lds_raw[];
    LAS unsigned char* lds = (LAS unsigned char*)lds_raw;
    cg::grid_group grid = cg::this_grid();
    unsigned char* ws = a.ws;
    const int G = gridDim.x, c = blockIdx.x;

    phase_prep(a, lds);
    grid.sync();
    {
        g8::DenseOrder S{(const char*)(ws + WS_XB), (const char*)(ws + WS_WIN0), 2048, 2048, NTOK / 256, 16, G, c};
        g8::EpiGroups E{(bf16_t*)(ws + WS_P), (const float*)(ws + WS_RS), 2, 512, GRP0 / 2};
        g8::gemm_phase<g8::EpiGroups, g8::DenseOrder>(lds, 2048, 2048, 1024, S, E);
    }
    grid.sync();
    phase_mix0_simple(a, lds);
    grid.sync();
    phase_post0(a);
    grid.sync();
    {
        g8::DenseOrder S{(const char*)(ws + WS_O0), (const char*)(ws + WS_WOUT0), 2048, 2048, NTOK / 256, 4, G, c};
        g8::EpiRes E{a.in[0], a.out, (bf16_t*)(ws + WS_XB)};
        g8::gemm_phase<g8::EpiRes, g8::DenseOrder>(lds, 2048, 2048, 1024, S, E);
    }
    grid.sync();
    phase_moe_simple<false>(a, 0, lds);
    grid.sync();
    {
        g8::DenseOrder S{(const char*)(ws + WS_XB), (const char*)(ws + WS_WIN1), 2048, 2048, NTOK / 256, 24, G, c};
        g8::EpiOdd E{(bf16_t*)(ws + WS_PQ), (bf16_t*)(ws + WS_PK), (bf16_t*)(ws + WS_PV), (bf16_t*)(ws + WS_PG), (const float*)(ws + WS_RS)};
        g8::gemm_phase<g8::EpiOdd, g8::DenseOrder>(lds, 2048, 2048, 1024, S, E);
    }
    grid.sync();
    phase_ret_simple(a, lds);
    grid.sync();
    phase_post1(a);
    grid.sync();
    {
        g8::DenseOrder S{(const char*)(ws + WS_PV), (const char*)(ws + WS_WOUT1), 4096, 4096, NTOK / 256, 4, G, c};
        g8::EpiRes E{a.out, a.out, (bf16_t*)(ws + WS_XB)};
        g8::gemm_phase<g8::EpiRes, g8::DenseOrder>(lds, 4096, 4096, 2048, S, E);
    }
    grid.sync();
    phase_moe_simple<true>(a, 1, lds);
}

extern "C" void kernel_launch(void* const* d_in, const int* in_sizes, int n_in, void* d_out, int out_size, void* d_ws, size_t ws_size, hipStream_t stream) {
    static int grid_blocks = 0;
    if (!grid_blocks) {
        if (ws_size < WS_END || n_in != 21) { fprintf(stderr, "kernel_launch: ws %zu < %zu or n_in %d\n", ws_size, (size_t)WS_END, n_in); grid_blocks = -1; return; }
        int dev = 0, cus = 0, per_cu = 0;
        (void)hipGetDevice(&dev);
        (void)hipDeviceGetAttribute(&cus, hipDeviceAttributeMultiprocessorCount, dev);
        (void)hipFuncSetAttribute((const void*)mega, hipFuncAttributeMaxDynamicSharedMemorySize, LDS_BYTES);
        (void)hipOccupancyMaxActiveBlocksPerMultiprocessor(&per_cu, (const void*)mega, NTHREADS, LDS_BYTES);
        if (per_cu < 1) { fprintf(stderr, "kernel_launch: occupancy query says %d blocks per CU\n", per_cu); grid_blocks = -1; return; }
        grid_blocks = cus;
    }
    if (grid_blocks < 0) return;
    Args a{};
    for (int i = 0; i < 21; ++i) a.in[i] = (const float*)d_in[i];
    a.out = (float*)d_out; a.ws = (unsigned char*)d_ws;
    void* args[] = {&a};
    hipError_t e = hipLaunchCooperativeKernel((const void*)mega, dim3(grid_blocks), dim3(NTHREADS), args, LDS_BYTES, stream);
    if (e != hipSuccess) fprintf(stderr, "cooperative launch failed: %s (grid %d)\n", hipGetErrorString(e), grid_blocks);
}
```

```cpp
#include <hip/hip_runtime.h>
#include <hip/hip_cooperative_groups.h>
#include <cstdint>
#include <cstdio>
namespace cg = cooperative_groups;

#define D_MODEL 1024
#define BATCH 4
#define SEQ 4096
#define NTOK (BATCH * SEQ)
#define EVEN_IN 4104
#define ODD_IN 6144
#define NTHREADS 512
#define NWAVES 8

__device__ __forceinline__ float sigmoidf_(float x) { return 1.0f / (1.0f + __expf(-x)); }
__device__ __forceinline__ float siluf_(float x) { return x / (1.0f + __expf(-x)); }
__device__ __forceinline__ float softplusf_(float x) { return x > 20.f ? x : log1pf(__expf(x)); }
__device__ __forceinline__ float bf2f(unsigned short b) { return __uint_as_float(((unsigned)b) << 16); }
__device__ __forceinline__ float wave_sum(float v) { for (int o = 32; o > 0; o >>= 1) v += __shfl_xor(v, o); return v; }

namespace g8 {
#define G8_LAS __attribute__((address_space(3)))
typedef unsigned short bf16_t;
typedef short bf16x8 __attribute__((ext_vector_type(8)));
typedef float f32x4 __attribute__((ext_vector_type(4)));
typedef unsigned u32x4 __attribute__((ext_vector_type(4)));
typedef unsigned u32x2 __attribute__((ext_vector_type(2)));
constexpr int BM = 256, BK = 64, HALF = 128, HTB = HALF * BK * 2, STAGE_BYTES = 8 * HTB;

__host__ __device__ __forceinline__ int lds_byte(int r, int c) { const int st = (r >> 4) * 2 + (c >> 5), rr = r & 15, cc = c & 31, ob = rr * 64 + cc * 2; return st * 1024 + (ob ^ (((ob >> 9) & 1) << 5)); }
__host__ __device__ __forceinline__ void stage_rc(int b, int& R, int& C) { const int st = b / 1024, sb = b % 1024, swz = sb ^ (((sb >> 9) & 1) << 5); R = (st >> 1) * 16 + swz / 64; C = (st & 1) * 32 + (swz % 64) / 2; }
__host__ __device__ __forceinline__ int perm32(int rho) { const int n = rho >> 4, i = rho & 15; return 8 * (i >> 2) + 4 * n + (i & 3); }
__device__ __forceinline__ unsigned cvt_pk_bf16(float lo, float hi) { unsigned r; asm volatile("v_cvt_pk_bf16_f32 %0, %1, %2" : "=v"(r) : "v"(lo), "v"(hi)); return r; }

struct Unit { const char* a; const char* b; int pm, pn, aux0, aux1; };

template <class Epi, class Sched, bool GATHER = false>
__device__ __forceinline__ void gemm_phase(G8_LAS unsigned char* lds, const int lda, const int ldb, const int K, const Sched& S, const Epi& E) {
    const int tid = threadIdx.x, wid = __builtin_amdgcn_readfirstlane(tid >> 6), lane = tid & 63, wr = wid >> 2, wc = wid & 3, fr = lane & 15, fq = lane >> 4;
    const int nt = K / BK;
    unsigned voffB[2];
#pragma unroll
    for (int i = 0; i < 2; ++i) { int R, C; stage_rc(tid * 16 + i * 8192, R, C); const int Rb = (R & ~31) + perm32(R & 31);
        voffB[i] = (unsigned)(Rb * ldb + C * 2); }
    unsigned vA[2][2], vAn[2][2];
    const size_t kstep = (size_t)(BK * 2);
    const size_t hstepB = (size_t)HALF * ldb;
    const unsigned ldsw = (unsigned)wid * 1024u;
    const int aoff = lds_byte(wr * 64 + fr, fq * 8), boff = lds_byte(wc * 32 + fr, fq * 8);
#define G8_SA(b, h) (((b) * 2 + (h)) * HTB)
#define G8_SB(b, h) ((4 + (b) * 2 + (h)) * HTB)
#define G8_STAGE(bufoff, gbase, voff) do { _Pragma("unroll") for (int _i = 0; _i < 2; ++_i) \
        __builtin_amdgcn_global_load_lds((const unsigned*)((const char*)(gbase) + (voff)[_i]), (G8_LAS unsigned*)(lds + (bufoff) + ldsw + _i * 8192), 16, 0, 0); } while (0)
#define G8_SETV(V, u) do { int _t = tid; asm volatile("" : "+v"(_t)); _Pragma("unroll") for (int _i = 0; _i < 2; ++_i) { int _R, _C; stage_rc(_t * 16 + _i * 8192, _R, _C); \
        _Pragma("unroll") for (int _h = 0; _h < 2; ++_h) V[_h][_i] = (GATHER ? S.rowoff(u, _h * HALF + _R) : (unsigned)((_h * HALF + _R) * lda)) + (unsigned)(_C * 2); } } while (0)
#define G8_LDA(dst, b, h) do { _Pragma("unroll") for (int m = 0; m < 4; ++m) _Pragma("unroll") for (int k = 0; k < 2; ++k) dst[m][k] = *(const G8_LAS bf16x8*)(lds + G8_SA(b, h) + aoff + m * 2048 + k * 1024); } while (0)
#define G8_LDB(dst, b, h) do { _Pragma("unroll") for (int n = 0; n < 2; ++n) _Pragma("unroll") for (int k = 0; k < 2; ++k) dst[n][k] = *(const G8_LAS bf16x8*)(lds + G8_SB(b, h) + boff + n * 2048 + k * 1024); } while (0)
#define G8_MMA(ai, bj, At, Bt) do { __builtin_amdgcn_s_setprio(1); _Pragma("unroll") for (int m = 0; m < 4; ++m) _Pragma("unroll") for (int n = 0; n < 2; ++n) _Pragma("unroll") for (int k = 0; k < 2; ++k) \
        acc[ai][bj][m][n] = __builtin_amdgcn_mfma_f32_16x16x32_bf16(Bt[n][k], At[m][k], acc[ai][bj][m][n], 0, 0, 0); __builtin_amdgcn_s_setprio(0); } while (0)
#define G8_WAIT_V(n) asm volatile("s_waitcnt vmcnt(" #n ")" ::: "memory")
#define G8_WAIT_L(n) asm volatile("s_waitcnt lgkmcnt(" #n ")" ::: "memory")
#define G8_BAR __builtin_amdgcn_s_barrier()
#define G8_SCHED __builtin_amdgcn_sched_barrier(0)
    Unit cur, nxt; int ui = 0;
    if (!S.next(0, cur)) return;
    f32x4 acc[2][2][4][2];
#pragma unroll
    for (int a = 0; a < 2; ++a)
#pragma unroll
        for (int b = 0; b < 2; ++b)
#pragma unroll
            for (int m = 0; m < 4; ++m)
#pragma unroll
                for (int n = 0; n < 2; ++n) acc[a][b][m][n] = (f32x4){0.f, 0.f, 0.f, 0.f};
    bf16x8 At[4][2], B0[2][2], B1[2][2];
    const char* cA = cur.a; const char* cB = cur.b;
    G8_SETV(vA, cur);
    if (GATHER) asm volatile("s_waitcnt vmcnt(0)" ::: "memory");
    G8_STAGE(G8_SB(0, 0), cB, voffB); G8_STAGE(G8_SA(0, 0), cA, vA[0]); G8_STAGE(G8_SB(0, 1), cB + hstepB, voffB); G8_STAGE(G8_SA(0, 1), cA, vA[1]);
    if (wr == 1) G8_BAR;
    G8_WAIT_V(4); G8_BAR;
    G8_STAGE(G8_SB(1, 0), cB + kstep, voffB); G8_STAGE(G8_SA(1, 0), cA + kstep, vA[0]); G8_STAGE(G8_SB(1, 1), cB + hstepB + kstep, voffB);
    G8_WAIT_V(6); G8_BAR;
    for (;;) {
        const bool has_next = S.next(ui + 1, nxt);
        const char* nA = has_next ? nxt.a : cA; const char* nB = has_next ? nxt.b : cB;
        if (GATHER && has_next) { G8_SETV(vAn, nxt); }
        else {
#pragma unroll
            for (int _h = 0; _h < 2; ++_h)
#pragma unroll
                for (int _i = 0; _i < 2; ++_i) vAn[_h][_i] = vA[_h][_i]; }
        for (int t = 0; t < nt; t += 2) {
            const bool last = (t == nt - 2);
            const char* a1 = cA + (size_t)(t + 1) * kstep;
            const char* a2 = last ? nA : cA + (size_t)(t + 2) * kstep; const char* b2 = last ? nB : cB + (size_t)(t + 2) * kstep;
            const char* a3 = a2 + kstep; const char* b3 = b2 + kstep;
            unsigned o2[2][2];
#pragma unroll
            for (int _h = 0; _h < 2; ++_h)
#pragma unroll
                for (int _i = 0; _i < 2; ++_i) o2[_h][_i] = (GATHER && last) ? vAn[_h][_i] : vA[_h][_i];
            G8_LDB(B0, 0, 0); G8_SCHED; G8_LDA(At, 0, 0); G8_STAGE(G8_SA(1, 1), a1, vA[1]);
            G8_WAIT_L(8); G8_BAR; G8_WAIT_L(0); G8_MMA(0, 0, At, B0); G8_BAR; G8_SCHED;
            G8_LDB(B1, 0, 1); G8_STAGE(G8_SB(0, 0), b2, voffB);
            G8_BAR; G8_WAIT_L(0); G8_MMA(0, 1, At, B1); G8_BAR;
            G8_LDA(At, 0, 1); G8_STAGE(G8_SA(0, 0), a2, o2[0]);
            G8_BAR; G8_WAIT_L(0); G8_MMA(1, 0, At, B0); G8_BAR; G8_SCHED;
            G8_STAGE(G8_SB(0, 1), b2 + hstepB, voffB);
            G8_WAIT_V(6); G8_BAR; G8_MMA(1, 1, At, B1); G8_BAR;
            G8_LDB(B0, 1, 0); G8_SCHED; G8_LDA(At, 1, 0); G8_STAGE(G8_SA(0, 1), a2, o2[1]);
            G8_WAIT_L(8); G8_BAR; G8_WAIT_L(0); G8_MMA(0, 0, At, B0); G8_BAR; G8_SCHED;
            G8_LDB(B1, 1, 1); G8_STAGE(G8_SB(1, 0), b3, voffB);
            G8_BAR; G8_WAIT_L(0); G8_MMA(0, 1, At, B1); G8_BAR;
            G8_LDA(At, 1, 1); G8_STAGE(G8_SA(1, 0), a3, o2[0]);
            G8_BAR; G8_WAIT_L(0); G8_MMA(1, 0, At, B0); G8_BAR; G8_SCHED;
            G8_STAGE(G8_SB(1, 1), b3 + hstepB, voffB);
            G8_WAIT_V(6); G8_BAR; G8_MMA(1, 1, At, B1); G8_BAR;
        }
        { int fr_ = fr, fq_ = fq; asm volatile("" : "+v"(fr_), "+v"(fq_)); E(acc, cur, wr, wc, fr_, fq_); }
        if (!has_next) break;
#pragma unroll
        for (int a = 0; a < 2; ++a)
#pragma unroll
            for (int b = 0; b < 2; ++b)
#pragma unroll
                for (int m = 0; m < 4; ++m)
#pragma unroll
                    for (int n = 0; n < 2; ++n) acc[a][b][m][n] = (f32x4){0.f, 0.f, 0.f, 0.f};
        cur = nxt; cA = nA; cB = nB; ++ui;
#pragma unroll
        for (int _h = 0; _h < 2; ++_h)
#pragma unroll
            for (int _i = 0; _i < 2; ++_i) vA[_h][_i] = vAn[_h][_i];
    }
    G8_WAIT_V(0);
    if (wr == 0) G8_BAR;
    G8_BAR;
#undef G8_SA
#undef G8_SB
#undef G8_STAGE
#undef G8_SETV
#undef G8_LDA
#undef G8_LDB
#undef G8_MMA
#undef G8_WAIT_V
#undef G8_WAIT_L
#undef G8_BAR
#undef G8_SCHED
}


struct DenseOrder {
    const char* A; const char* B; int lda, ldb, nM, nN, G, c;
    __device__ __forceinline__ bool next(int i, Unit& u) const {
        const int L = i * G + c; if (L >= nM * nN) return false;
        const int grp = L / (8 * nN), rem = L % (8 * nN); const int gsz = (nM - grp * 8) < 8 ? (nM - grp * 8) : 8;
        u.pm = grp * 8 + rem % gsz; u.pn = rem / gsz;
        u.a = A + (size_t)u.pm * BM * lda; u.b = B + (size_t)u.pn * BM * ldb; u.aux0 = 0; u.aux1 = 0; return true;
    }
    __device__ __forceinline__ unsigned rowoff(const Unit&, int) const { return 0u; }
};

struct EpiGroups {
    bf16_t* dst; const float* rs; int upg; int ld; size_t gstride;
    __device__ __forceinline__ void operator()(const f32x4 (&acc)[2][2][4][2], const Unit& u, int wr, int wc, int fr, int fq) const {
        const int row0 = u.pm * BM + wr * 64 + fr;
        bf16_t* base = dst + (size_t)(u.pn / upg) * gstride + (u.pn % upg) * 256 + wc * 32 + 8 * fq;
#pragma unroll
        for (int ai = 0; ai < 2; ++ai)
#pragma unroll
            for (int m = 0; m < 4; ++m) { const int row = row0 + ai * HALF + m * 16; const float sc = rs[row]; bf16_t* rowp = base + (size_t)row * ld;
#pragma unroll
                for (int bj = 0; bj < 2; ++bj) { const f32x4 v0 = acc[ai][bj][m][0] * sc, v1 = acc[ai][bj][m][1] * sc;
                    u32x4 w; w.x = cvt_pk_bf16(v0[0], v0[1]); w.y = cvt_pk_bf16(v0[2], v0[3]); w.z = cvt_pk_bf16(v1[0], v1[1]); w.w = cvt_pk_bf16(v1[2], v1[3]);
                    *(u32x4*)(rowp + bj * HALF) = w; } }
    }
};
struct EpiOdd {
    bf16_t* pq; bf16_t* pk; bf16_t* pv; bf16_t* pg; const float* rowss;
    __device__ __forceinline__ void operator()(const f32x4 (&acc)[2][2][4][2], const Unit& u, int wr, int wc, int fr, int fq) const {
        const int row0 = u.pm * BM + wr * 64 + fr;
        bf16_t* base; int ld, ct;
        if (u.pn < 4) { base = pq; ld = 1024; ct = u.pn; } else if (u.pn < 8) { base = pk; ld = 1024; ct = u.pn - 4; }
        else if (u.pn < 16) { base = pv; ld = 2048; ct = u.pn - 8; } else { base = pg; ld = 2048; ct = u.pn - 16; }
        base += ct * 256 + wc * 32 + 8 * fq;
#pragma unroll
        for (int ai = 0; ai < 2; ++ai)
#pragma unroll
            for (int m = 0; m < 4; ++m) { const int row = row0 + ai * HALF + m * 16; const float sc = rsqrtf(rowss[row] * (1.0f / 1024.0f) + 1e-6f); bf16_t* rowp = base + (size_t)row * ld;
#pragma unroll
                for (int bj = 0; bj < 2; ++bj) { const f32x4 v0 = acc[ai][bj][m][0] * sc, v1 = acc[ai][bj][m][1] * sc;
                    u32x4 w; w.x = cvt_pk_bf16(v0[0], v0[1]); w.y = cvt_pk_bf16(v0[2], v0[3]); w.z = cvt_pk_bf16(v1[0], v1[1]); w.w = cvt_pk_bf16(v1[2], v1[3]);
                    *(u32x4*)(rowp + bj * HALF) = w; } }
    }
};
struct EpiRes {
    const float* xin; float* xout; bf16_t* xb;
    __device__ __forceinline__ void operator()(const f32x4 (&acc)[2][2][4][2], const Unit& u, int wr, int wc, int fr, int fq) const {
        const int row0 = u.pm * BM + wr * 64 + fr; const int col0 = u.pn * BM + wc * 32 + 8 * fq;
#pragma unroll
        for (int ai = 0; ai < 2; ++ai)
#pragma unroll
            for (int m = 0; m < 4; ++m) { const size_t ro = (size_t)(row0 + ai * HALF + m * 16) * 1024 + col0;
#pragma unroll
                for (int bj = 0; bj < 2; ++bj) {
                    const f32x4 r0 = *(const f32x4*)(xin + ro + bj * HALF), r1 = *(const f32x4*)(xin + ro + bj * HALF + 4);
                    const f32x4 v0 = acc[ai][bj][m][0] + r0, v1 = acc[ai][bj][m][1] + r1;
                    *(f32x4*)(xout + ro + bj * HALF) = v0; *(f32x4*)(xout + ro + bj * HALF + 4) = v1;
                    u32x4 w; w.x = cvt_pk_bf16(v0[0], v0[1]); w.y = cvt_pk_bf16(v0[2], v0[3]); w.z = cvt_pk_bf16(v1[0], v1[1]); w.w = cvt_pk_bf16(v1[2], v1[3]);
                    *(u32x4*)(xb + ro + bj * HALF) = w; } }
    }
};
}
typedef g8::bf16_t bf16_t;
typedef g8::u32x4 u32x4;
typedef g8::u32x2 u32x2;
#define LAS __attribute__((address_space(3)))

constexpr size_t MiB = (size_t)1 << 20;
constexpr size_t WS_RS = 64 * 1024;
constexpr size_t WS_GATES = 128 * 1024;
constexpr size_t WS_XB = 4 * MiB;
constexpr size_t WS_WIN0 = 36 * MiB;
constexpr size_t WS_WOUT0 = 44 * MiB;
constexpr size_t WS_WIN1 = 46 * MiB;
constexpr size_t WS_WOUT1 = 58 * MiB;
constexpr size_t WS_P = 62 * MiB;
constexpr size_t GRP0 = 16 * MiB;
constexpr size_t WS_O0 = WS_P + 8 * GRP0;
constexpr size_t WS_PQ = WS_P, WS_PK = WS_P + 32 * MiB, WS_PV = WS_P + 64 * MiB, WS_PG = WS_P + 128 * MiB;
constexpr size_t WS_END = WS_P + 192 * MiB;
constexpr size_t WS_CNT = 1024;
constexpr size_t WS_ROWSS = 1 * MiB;
constexpr size_t WS_ROWREC = WS_WIN0;
constexpr size_t WS_WGU = WS_P;
constexpr size_t WS_WDN = WS_P + 16 * MiB;
constexpr size_t WS_ACT = WS_P + 40 * MiB;
constexpr int LDS_TAB = g8::STAGE_BYTES;
constexpr int LDS_BYTES = g8::STAGE_BYTES + 1024;

struct Args { const float* in[21]; float* out; unsigned char* ws; };

__device__ __forceinline__ void conv_tile(const float* __restrict__ W, int ldw, int srccol0, const float* __restrict__ scale, bf16_t* __restrict__ Wt, int K, int k0, int n0, LAS float* tile, int ks0 = -1) {
    if (ks0 < 0) ks0 = k0;
    const int t = threadIdx.x;
    for (int i = t; i < 64 * 64; i += NTHREADS) { const int kk = i >> 6, nn = i & 63; float v = W[(size_t)(ks0 + kk) * ldw + srccol0 + nn]; if (scale) v *= scale[ks0 + kk]; tile[kk * 65 + nn] = v; }
    __syncthreads();
    { const int nn = t >> 3, kc = t & 7;
      u32x4 o; o.x = g8::cvt_pk_bf16(tile[(kc * 8 + 0) * 65 + nn], tile[(kc * 8 + 1) * 65 + nn]); o.y = g8::cvt_pk_bf16(tile[(kc * 8 + 2) * 65 + nn], tile[(kc * 8 + 3) * 65 + nn]);
      o.z = g8::cvt_pk_bf16(tile[(kc * 8 + 4) * 65 + nn], tile[(kc * 8 + 5) * 65 + nn]); o.w = g8::cvt_pk_bf16(tile[(kc * 8 + 6) * 65 + nn], tile[(kc * 8 + 7) * 65 + nn]);
      *(u32x4*)(Wt + (size_t)(n0 + nn) * K + k0 + kc * 8) = o; }
    __syncthreads();
}

__device__ __forceinline__ void phase_prep(const Args& a, LAS unsigned char* lds) {
    const float* x = a.in[0]; const float* nmw = a.in[1];
    const float* w_in0 = a.in[3]; const float* a_log = a.in[5]; const float* dt_bias = a.in[6];
    unsigned char* ws = a.ws;
    LAS float* Wg8 = (LAS float*)lds;
    LAS float* tile = (LAS float*)(lds + 32768);
    const int tid = threadIdx.x, lane = tid & 63, wave = tid >> 6;
    for (int i = tid; i < 1024 * 8; i += NTHREADS) { const int k = i >> 3, j = i & 7; Wg8[i] = w_in0[(size_t)k * EVEN_IN + 2048 + j] * nmw[k]; }
    __syncthreads();
    float* RS = (float*)(ws + WS_RS); float* GATES = (float*)(ws + WS_GATES); bf16_t* XB = (bf16_t*)(ws + WS_XB);
    for (int m = blockIdx.x * NWAVES + wave; m < NTOK; m += gridDim.x * NWAVES) {
        const float4* xr = (const float4*)(x + (size_t)m * D_MODEL) + lane;
        float4 v[4]; float s = 0.f;
#pragma unroll
        for (int j = 0; j < 4; ++j) { v[j] = xr[64 * j]; s += v[j].x * v[j].x + v[j].y * v[j].y + v[j].z * v[j].z + v[j].w * v[j].w; }
        s = wave_sum(s);
        const float rs = rsqrtf(s * (1.0f / D_MODEL) + 1e-6f);
        float g[8];
#pragma unroll
        for (int q = 0; q < 8; ++q) g[q] = 0.f;
#pragma unroll
        for (int j = 0; j < 4; ++j) {
            const float xv[4] = {v[j].x, v[j].y, v[j].z, v[j].w};
#pragma unroll
            for (int e = 0; e < 4; ++e) { const int k = 256 * j + 4 * lane + e;
#pragma unroll
                for (int q = 0; q < 8; ++q) g[q] = fmaf(xv[e], Wg8[k * 8 + q], g[q]); }
            u32x2 o; o.x = g8::cvt_pk_bf16(v[j].x, v[j].y); o.y = g8::cvt_pk_bf16(v[j].z, v[j].w);
            *((u32x2*)(XB + (size_t)m * D_MODEL) + lane + 64 * j) = o;
        }
#pragma unroll
        for (int q = 0; q < 8; ++q) g[q] = wave_sum(g[q]) * rs;
        if (lane == 0) {
            RS[m] = rs;
#pragma unroll
            for (int h = 0; h < 4; ++h) { GATES[(size_t)m * 8 + h] = sigmoidf_(g[h]); GATES[(size_t)m * 8 + 4 + h] = -__expf(a_log[h]) * softplusf_(g[4 + h] + dt_bias[h]); }
        }
    }
    for (int i = blockIdx.x * NTHREADS + tid; i < 2 * NTOK; i += gridDim.x * NTHREADS) ((float*)(ws + WS_ROWSS))[i] = 0.f;
    if (blockIdx.x == 0 && tid < 64) ((int*)(ws + WS_CNT))[tid] = 0;
    constexpr int I0 = 16 * 64, I1 = 16 * 16, I2 = 16 * 96, I3 = 32 * 16;
    for (int it = blockIdx.x; it < I0 + I1 + I2 + I3; it += gridDim.x) {
        int r = it;
        if (r < I0) { const int k0 = (r / 64) * 64, n0 = (r % 64) * 64; conv_tile(w_in0, EVEN_IN, n0 + (n0 >= 2048 ? 8 : 0), nmw, (bf16_t*)(ws + WS_WIN0), 1024, k0, n0, tile); continue; } r -= I0;
        if (r < I1) { const int k0 = (r / 16) * 64, n0 = (r % 16) * 64; conv_tile(a.in[10], 1024, n0, nullptr, (bf16_t*)(ws + WS_WOUT0), 1024, k0, n0, tile); continue; } r -= I1;
        if (r < I2) { const int k0 = (r / 96) * 64, n0 = (r % 96) * 64; conv_tile(a.in[11], ODD_IN, n0, nmw + 1024, (bf16_t*)(ws + WS_WIN1), 1024, k0, n0, tile); continue; } r -= I2;
        { const int k0 = (r / 16) * 64, n0 = (r % 16) * 64; conv_tile(a.in[13], 1024, n0, nullptr, (bf16_t*)(ws + WS_WOUT1), 2048, k0, n0, tile); }
    }
}

__device__ __forceinline__ void phase_mix0_simple(const Args& a, LAS unsigned char* lds) {
    unsigned char* ws = a.ws;
    const int item = blockIdx.x; if (item >= 32) return;
    const int c = threadIdx.x; const bool act = c < 128; const int cc = c & 127;
    const int bh = item & 15, b = bh >> 2, h = bh & 3;
    LAS float* qs = (LAS float*)lds; LAS float* ks = qs + 128; LAS float* fs = ks + 128; LAS float* red = fs + 128;
    bf16_t* O = (bf16_t*)(ws + WS_O0);
    const float scale = 0.08838834764831845f;
    if (item < 16) {
        const bool act2 = c < 256; const int half = (c >> 7) & 1;
        LAS float* red2 = red + 8;
        float S[64];
#pragma unroll
        for (int i = 0; i < 64; ++i) S[i] = 0.f;
        const bf16_t* Gq = (const bf16_t*)(ws + WS_P); const bf16_t* Gk = (const bf16_t*)(ws + WS_P + GRP0); const bf16_t* Gv = (const bf16_t*)(ws + WS_P + 2 * GRP0);
        const float* GATES = (const float*)(ws + WS_GATES); const float* cw = a.in[4];
        float wq[4], wk[4], wv[4];
#pragma unroll
        for (int j = 0; j < 4; ++j) { wq[j] = cw[j * 1536 + h * 128 + cc]; wk[j] = cw[j * 1536 + 512 + h * 128 + cc]; wv[j] = cw[j * 1536 + 1024 + h * 128 + cc]; }
        float hq0 = 0.f, hq1 = 0.f, hq2 = 0.f, hk0 = 0.f, hk1 = 0.f, hk2 = 0.f, hv0 = 0.f, hv1 = 0.f, hv2 = 0.f;
        for (int t = 0; t < SEQ; ++t) {
            const size_t tok = (size_t)b * SEQ + t;
            float q = 0.f, k = 0.f, v = 0.f;
            if (act2) {
                const float xq = bf2f(Gq[tok * 512 + h * 128 + cc]), xk = bf2f(Gk[tok * 512 + h * 128 + cc]), xv = bf2f(Gv[tok * 512 + h * 128 + cc]);
                q = siluf_(hq0 * wq[0] + hq1 * wq[1] + hq2 * wq[2] + xq * wq[3]); hq0 = hq1; hq1 = hq2; hq2 = xq;
                k = siluf_(hk0 * wk[0] + hk1 * wk[1] + hk2 * wk[2] + xk * wk[3]); hk0 = hk1; hk1 = hk2; hk2 = xk;
                v = siluf_(hv0 * wv[0] + hv1 * wv[1] + hv2 * wv[2] + xv * wv[3]); hv0 = hv1; hv1 = hv2; hv2 = xv;
                const float sq = wave_sum(q * q), sk = wave_sum(k * k);
                if (c < 128 && (c & 63) == 0) { red[(c >> 6) * 2] = sq; red[(c >> 6) * 2 + 1] = sk; }
            }
            __syncthreads();
            if (act) { qs[cc] = q * rsqrtf(red[0] + red[2] + 1e-6f); ks[cc] = k * rsqrtf(red[1] + red[3] + 1e-6f); }
            __syncthreads();
            float be = 0.f, aa = 0.f;
            if (act2) {
                be = GATES[tok * 8 + h]; aa = __expf(GATES[tok * 8 + 4 + h]);
                float kd = 0.f;
#pragma unroll
                for (int i = 0; i < 64; ++i) { S[i] *= aa; kd = fmaf(ks[half * 64 + i], S[i], kd); }
                red2[c] = kd;
            }
            __syncthreads();
            float oo = 0.f;
            if (act2) {
                const float r = be * (v - (red2[cc] + red2[128 + cc]));
#pragma unroll
                for (int i = 0; i < 64; ++i) { S[i] = fmaf(ks[half * 64 + i], r, S[i]); oo = fmaf(qs[half * 64 + i], S[i], oo); }
            }
            __syncthreads();
            if (act2 && half == 1) red2[cc] = oo;
            __syncthreads();
            if (act) O[tok * 1024 + h * 128 + cc] = (bf16_t)(g8::cvt_pk_bf16((oo + red2[cc]) * scale, 0.f) & 0xffffu);
        }
    } else {
        const bf16_t* Hq = (const bf16_t*)(ws + WS_P + 4 * GRP0); const bf16_t* Hf = (const bf16_t*)(ws + WS_P + 5 * GRP0); const bf16_t* Hi = (const bf16_t*)(ws + WS_P + 6 * GRP0);
        const float* lbl = a.in[8];
        float S[128];
#pragma unroll
        for (int i = 0; i < 128; ++i) S[i] = 0.f;
        float lb;
        { const int ch = h * 128 + cc; const float l0 = lbl[ch], l1 = lbl[512 + ch], l2 = lbl[1024 + ch]; const float mx = fmaxf(l0, fmaxf(l1, l2));
          const float e0 = __expf(l0 - mx), e1 = __expf(l1 - mx), e2 = __expf(l2 - mx); lb = e0 / (e0 + e1 + e2); }
        for (int t = 0; t < SEQ; ++t) {
            const size_t tok = (size_t)b * SEQ + t;
            float iv = 0.f;
            if (act) {
                const float xq = bf2f(Hq[tok * 512 + h * 128 + cc]), xf = bf2f(Hf[tok * 512 + h * 128 + cc]); iv = bf2f(Hi[tok * 512 + h * 128 + cc]);
                const float f = lb + (1.f - lb) * sigmoidf_(xf);
                qs[cc] = siluf_(xq); fs[cc] = f; ks[cc] = 1.f - f;
            }
            __syncthreads();
            if (act) {
                float oo = 0.f;
#pragma unroll
                for (int i0 = 0; i0 < 128; i0 += 16) {
#pragma unroll
                    for (int i = i0; i < i0 + 16; ++i) { S[i] = fmaf(fs[i], S[i], ks[i] * iv); oo = fmaf(qs[i], S[i], oo); }
                    asm volatile("" ::: "memory"); }
                O[tok * 1024 + 512 + h * 128 + cc] = (bf16_t)(g8::cvt_pk_bf16(oo * scale, 0.f) & 0xffffu);
            }
            __syncthreads();
        }
    }
}

__device__ __forceinline__ void phase_post0(const Args& a) {
    unsigned char* ws = a.ws;
    bf16_t* O = (bf16_t*)(ws + WS_O0);
    const bf16_t* Gz = (const bf16_t*)(ws + WS_P + 3 * GRP0); const bf16_t* Hg = (const bf16_t*)(ws + WS_P + 7 * GRP0);
    const float* gnw = a.in[7]; const float* hnw = a.in[9];
    const int lane = threadIdx.x & 63, wave = threadIdx.x >> 6;
    const int hd = lane >> 3;
    const float* nw = hd < 4 ? gnw : hnw;
    for (int m = blockIdx.x * NWAVES + wave; m < NTOK; m += gridDim.x * NWAVES) {
        const u32x4* op = (const u32x4*)(O + (size_t)m * 1024 + 16 * lane);
        const bf16_t* zsrc = hd < 4 ? Gz + (size_t)m * 512 + 16 * lane : Hg + (size_t)m * 512 + 16 * lane - 512;
        const u32x4 o0 = op[0], o1 = op[1]; const u32x4 z0 = ((const u32x4*)zsrc)[0], z1 = ((const u32x4*)zsrc)[1];
        const unsigned ow[8] = {o0.x, o0.y, o0.z, o0.w, o1.x, o1.y, o1.z, o1.w}; const unsigned zw[8] = {z0.x, z0.y, z0.z, z0.w, z1.x, z1.y, z1.z, z1.w};
        float v[16], z[16]; float s = 0.f;
#pragma unroll
        for (int i = 0; i < 8; ++i) { v[2 * i] = __uint_as_float(ow[i] << 16); v[2 * i + 1] = __uint_as_float(ow[i] & 0xffff0000u); z[2 * i] = __uint_as_float(zw[i] << 16); z[2 * i + 1] = __uint_as_float(zw[i] & 0xffff0000u); }
#pragma unroll
        for (int i = 0; i < 16; ++i) s += v[i] * v[i];
        s += __shfl_xor(s, 1); s += __shfl_xor(s, 2); s += __shfl_xor(s, 4);
        const float rs = rsqrtf(s * (1.f / 128.f) + 1e-6f);
        unsigned r[8];
#pragma unroll
        for (int i = 0; i < 8; ++i) { const int c0 = (16 * lane + 2 * i) & 127;
            r[i] = g8::cvt_pk_bf16(v[2 * i] * rs * nw[c0] * siluf_(z[2 * i]), v[2 * i + 1] * rs * nw[c0 + 1] * siluf_(z[2 * i + 1])); }
        u32x4* wp = (u32x4*)(O + (size_t)m * 1024 + 16 * lane);
        wp[0] = (u32x4){r[0], r[1], r[2], r[3]}; wp[1] = (u32x4){r[4], r[5], r[6], r[7]};
    }
}

template <bool FINAL>
__device__ __forceinline__ void phase_moe_simple(const Args& a, int layer, LAS unsigned char* lds) {
    unsigned char* ws = a.ws;
    float* xio = a.out;
    const float* nw = a.in[2] + layer * 1024; const float* wc = a.in[14] + layer * 1024 * 4; const float* bc = a.in[15] + layer * 4;
    const float* wf = a.in[16] + layer * 1024 * 16; const float* bfp = a.in[17] + layer * 16;
    const float* wgu = a.in[18] + (size_t)layer * 16 * 1024 * 512; const float* wd = a.in[19] + (size_t)layer * 16 * 256 * 1024;
    const float* fw = a.in[20];
    bf16_t* XB = (bf16_t*)(ws + WS_XB); float* RS = (float*)(ws + WS_RS);
    LAS float* hs = (LAS float*)lds; LAS float* gu = hs + 1024; LAS float* actv = gu + 512; LAS float* red = actv + 256; LAS float* logits = red + 16; LAS float* selw = logits + 32; LAS int* sele = (LAS int*)(selw + 4);
    const int t = threadIdx.x;
    for (int tok = blockIdx.x; tok < NTOK; tok += gridDim.x) {
        float xv0 = xio[(size_t)tok * 1024 + t], xv1 = xio[(size_t)tok * 1024 + 512 + t];
        float s = wave_sum(xv0 * xv0 + xv1 * xv1);
        __syncthreads();
        if ((t & 63) == 0) red[t >> 6] = s;
        __syncthreads();
        s = 0.f;
#pragma unroll
        for (int i = 0; i < 8; ++i) s += red[i];
        const float rs = rsqrtf(s * (1.0f / D_MODEL) + 1e-6f);
        hs[t] = xv0 * rs * nw[t]; hs[512 + t] = xv1 * rs * nw[512 + t];
        __syncthreads();
        if (t < 20) {
            float acc = 0.f;
            if (t < 4) { for (int k = 0; k < 1024; ++k) acc = fmaf(hs[k], wc[k * 4 + t], acc); acc += bc[t]; }
            else { const int e = t - 4; for (int k = 0; k < 1024; ++k) acc = fmaf(hs[k], wf[k * 16 + e], acc); acc += bfp[e]; }
            logits[t] = acc;
        }
        __syncthreads();
        if (t == 0) {
            float mx = logits[0]; int gi = 0;
            for (int i = 1; i < 4; ++i) if (logits[i] > mx) { mx = logits[i]; gi = i; }
            float den = 0.f;
            for (int i = 0; i < 4; ++i) den += __expf(logits[i] - mx);
            const float gprob = 1.f / den;
            float f0 = logits[4 + gi * 4], f1 = logits[5 + gi * 4], f2 = logits[6 + gi * 4], f3 = logits[7 + gi * 4];
            const float fl[4] = {f0, f1, f2, f3};
            int e0 = 0; float m0 = fl[0];
            for (int i = 1; i < 4; ++i) if (fl[i] > m0) { m0 = fl[i]; e0 = i; }
            int e1 = -1; float m1 = -3.0e38f;
            for (int i = 0; i < 4; ++i) if (i != e0 && fl[i] > m1) { m1 = fl[i]; e1 = i; }
            const float p1 = __expf(m1 - m0);
            sele[0] = gi * 4 + e0; sele[1] = gi * 4 + e1;
            selw[0] = gprob / (1.f + p1); selw[1] = gprob * p1 / (1.f + p1);
        }
        __syncthreads();
        float o0 = 0.f, o1 = 0.f;
        for (int s2 = 0; s2 < 2; ++s2) {
            const int e = sele[s2]; const float gw = selw[s2];
            const float* W = wgu + (size_t)e * 1024 * 512;
            float g = 0.f;
            for (int k = 0; k < 1024; ++k) g = fmaf(hs[k], W[(size_t)k * 512 + t], g);
            gu[t] = g;
            __syncthreads();
            if (t < 256) actv[t] = siluf_(gu[t]) * gu[256 + t] * gw;
            __syncthreads();
            const float* Wd = wd + (size_t)e * 256 * 1024;
            for (int f = 0; f < 256; ++f) { const float av = actv[f]; o0 = fmaf(av, Wd[(size_t)f * 1024 + t], o0); o1 = fmaf(av, Wd[(size_t)f * 1024 + 512 + t], o1); }
        }
        xv0 += o0; xv1 += o1;
        float s3 = wave_sum(xv0 * xv0 + xv1 * xv1);
        __syncthreads();
        if ((t & 63) == 0) red[t >> 6] = s3;
        __syncthreads();
        s3 = 0.f;
#pragma unroll
        for (int i = 0; i < 8; ++i) s3 += red[i];
        const float rs2 = rsqrtf(s3 * (1.0f / D_MODEL) + 1e-6f);
        if (FINAL) { xio[(size_t)tok * 1024 + t] = xv0 * rs2 * fw[t]; xio[(size_t)tok * 1024 + 512 + t] = xv1 * rs2 * fw[512 + t]; }
        else {
            xio[(size_t)tok * 1024 + t] = xv0; xio[(size_t)tok * 1024 + 512 + t] = xv1;
            XB[(size_t)tok * 1024 + t] = (bf16_t)(g8::cvt_pk_bf16(xv0, 0.f) & 0xffffu); XB[(size_t)tok * 1024 + 512 + t] = (bf16_t)(g8::cvt_pk_bf16(xv1, 0.f) & 0xffffu);
            if (t == 0) RS[tok] = rs2;
        }
    }
}


__device__ __forceinline__ void moe_weight_items(const Args& a, int layer, LAS unsigned char* lds) {
    unsigned char* ws = a.ws;
    LAS float* tile = (LAS float*)lds;
    const float* wgu = a.in[18] + (size_t)layer * 16 * 1024 * 512; const float* wd = a.in[19] + (size_t)layer * 16 * 256 * 1024;
    const float* nw = a.in[2] + layer * 1024;
    constexpr int IG = 16 * 16 * 8, ID = 24 * 2 * 4 * 16;
    for (int it = blockIdx.x; it < IG + ID; it += gridDim.x) {
        if (it < IG) { const int e = it >> 7, r = it & 127, k0 = (r >> 3) * 64, n0 = (r & 7) * 64;
            const int u = n0 >> 8, hf = (n0 >> 7) & 1, j0 = n0 & 127;
            conv_tile(wgu + (size_t)e * 1024 * 512, 512, hf * 256 + u * 128 + j0, nw, (bf16_t*)(ws + WS_WGU) + (size_t)e * 512 * 1024, 1024, k0, n0, tile);
        } else { const int r = it - IG; const int bkt = r >> 7, q = r & 127, slot = q >> 6, kt = (q >> 4) & 3, n0 = (q & 15) * 64;
            const int g = bkt / 6, pr = bkt % 6; const int ei = pr < 3 ? 0 : (pr < 5 ? 1 : 2), ej = pr < 3 ? pr + 1 : (pr < 5 ? pr - 1 : 3);
            const int e = g * 4 + (slot ? ej : ei);
            conv_tile(wd + (size_t)e * 256 * 1024, 1024, n0, nullptr, (bf16_t*)(ws + WS_WDN) + (size_t)bkt * 1024 * 512, 512, slot * 256 + kt * 64, n0, tile, kt * 64);
        }
    }
}

__device__ __forceinline__ void phase_route(const Args& a, int layer, LAS unsigned char* lds) {
    unsigned char* ws = a.ws;
    const float* x = a.out;
    const float* nw = a.in[2] + layer * 1024; const float* wc = a.in[14] + layer * 1024 * 4; const float* bc = a.in[15] + layer * 4;
    const float* wf = a.in[16] + layer * 1024 * 16; const float* bfp = a.in[17] + layer * 16;
    int* cnt = (int*)(ws + WS_CNT) + layer * 32; int4* rec = (int4*)(ws + WS_ROWREC);
    LAS g8::f32x4* W20 = (LAS g8::f32x4*)lds;
    const int tid = threadIdx.x, lane = tid & 63, wave = tid >> 6;
    for (int i = tid; i < 5 * 1024; i += NTHREADS) { const int p = i >> 10, k = i & 1023; const float w = nw[k];
        g8::f32x4 v; if (p == 0) { v = (g8::f32x4){wc[k * 4] * w, wc[k * 4 + 1] * w, wc[k * 4 + 2] * w, wc[k * 4 + 3] * w}; }
        else { const float* q = wf + k * 16 + (p - 1) * 4; v = (g8::f32x4){q[0] * w, q[1] * w, q[2] * w, q[3] * w}; }
        W20[i] = v; }
    __syncthreads();
    for (int m = blockIdx.x * NWAVES + wave; m < NTOK; m += gridDim.x * NWAVES) {
        const float* xr = x + (size_t)m * D_MODEL + lane;
        float acc[20];
#pragma unroll
        for (int j = 0; j < 20; ++j) acc[j] = 0.f;
        float s = 0.f;
#pragma unroll 2
        for (int i = 0; i < 16; ++i) { const float xv = xr[64 * i]; s = fmaf(xv, xv, s); const int k = 64 * i + lane;
#pragma unroll
            for (int p = 0; p < 5; ++p) { const g8::f32x4 w = W20[p * 1024 + k]; acc[4 * p] = fmaf(xv, w[0], acc[4 * p]); acc[4 * p + 1] = fmaf(xv, w[1], acc[4 * p + 1]); acc[4 * p + 2] = fmaf(xv, w[2], acc[4 * p + 2]); acc[4 * p + 3] = fmaf(xv, w[3], acc[4 * p + 3]); } }
        s = wave_sum(s);
        const float rs = rsqrtf(s * (1.0f / D_MODEL) + 1e-6f);
#pragma unroll
        for (int j = 0; j < 20; ++j) acc[j] = wave_sum(acc[j]) * rs;
        if (lane == 0) {
            float c0 = acc[0] + bc[0], c1 = acc[1] + bc[1], c2 = acc[2] + bc[2], c3 = acc[3] + bc[3];
            int gi = 0; float mx = c0; if (c1 > mx) { mx = c1; gi = 1; } if (c2 > mx) { mx = c2; gi = 2; } if (c3 > mx) { mx = c3; gi = 3; }
            const float gprob = 1.f / (__expf(c0 - mx) + __expf(c1 - mx) + __expf(c2 - mx) + __expf(c3 - mx));
            float f0, f1, f2, f3;
            if (gi == 0) { f0 = acc[4]; f1 = acc[5]; f2 = acc[6]; f3 = acc[7]; } else if (gi == 1) { f0 = acc[8]; f1 = acc[9]; f2 = acc[10]; f3 = acc[11]; }
            else if (gi == 2) { f0 = acc[12]; f1 = acc[13]; f2 = acc[14]; f3 = acc[15]; } else { f0 = acc[16]; f1 = acc[17]; f2 = acc[18]; f3 = acc[19]; }
            f0 += bfp[gi * 4]; f1 += bfp[gi * 4 + 1]; f2 += bfp[gi * 4 + 2]; f3 += bfp[gi * 4 + 3];
            int e0 = 0; float m0 = f0; if (f1 > m0) { m0 = f1; e0 = 1; } if (f2 > m0) { m0 = f2; e0 = 2; } if (f3 > m0) { m0 = f3; e0 = 3; }
            int e1 = -1; float m1 = -3.0e38f;
            if (e0 != 0 && f0 > m1) { m1 = f0; e1 = 0; } if (e0 != 1 && f1 > m1) { m1 = f1; e1 = 1; } if (e0 != 2 && f2 > m1) { m1 = f2; e1 = 2; } if (e0 != 3 && f3 > m1) { m1 = f3; e1 = 3; }
            const float p1 = __expf(m1 - m0);
            const float w0 = gprob / (1.f + p1), w1 = gprob * p1 / (1.f + p1);
            const int lo = e0 < e1 ? e0 : e1, hi = e0 < e1 ? e1 : e0;
            const float wlo = e0 < e1 ? w0 : w1, whi = e0 < e1 ? w1 : w0;
            const int pr = lo == 0 ? hi - 1 : (lo == 1 ? hi + 1 : 5);
            const int bkt = gi * 6 + pr;
            const int pos = atomicAdd(cnt + bkt, 1);
            rec[(size_t)bkt * NTOK + pos] = make_int4(m, __float_as_int(rs), __float_as_int(wlo), __float_as_int(whi));
        }
    }
}

__device__ __forceinline__ void moe_table(const Args& a, int layer, LAS unsigned char* lds) {
    LAS int* tab = (LAS int*)(lds + LDS_TAB);
    const int* cnt = (const int*)(a.ws + WS_CNT) + layer * 32;
    if (threadIdx.x == 0) { int p = 0; for (int b = 0; b < 24; ++b) { const int c = __hip_atomic_load(cnt + b, __ATOMIC_RELAXED, __HIP_MEMORY_SCOPE_AGENT); tab[b] = p; tab[32 + b] = c; p += (c + 255) >> 8; } tab[24] = p; }
    __syncthreads();
}

namespace g8 {
struct MoeOrder {
    const char* A; const char* B; const int4* rec; G8_LAS const int* tab; int mode, G, c;
    __device__ __forceinline__ bool next(int i, Unit& u) const {
        const int L = i * G + c; if (L >= __builtin_amdgcn_readfirstlane(tab[24]) * 4) return false;
        const int p = L >> 2, pn = L & 3;
        int b = 0;
        for (int j = 1; j < 24; ++j) { const int tj = __builtin_amdgcn_readfirstlane(tab[j]); if (tj <= p) b = j; }
        const int pib = p - __builtin_amdgcn_readfirstlane(tab[b]); int nv = __builtin_amdgcn_readfirstlane(tab[32 + b]) - pib * 256; nv = nv > 256 ? 256 : nv;
        u.pm = p; u.pn = pn; u.aux0 = b * NTOK + pib * 256; u.aux1 = nv;
        if (mode == 0) { const int g = b / 6, pr = b % 6; const int ei = pr < 3 ? 0 : (pr < 5 ? 1 : 2), ej = pr < 3 ? pr + 1 : (pr < 5 ? pr - 1 : 3);
            const int e = g * 4 + ((pn >> 1) ? ej : ei);
            u.a = A; u.b = B + ((size_t)e * 512 + (pn & 1) * 256) * 2048; }
        else { u.a = A + (size_t)p * 256 * 1024; u.b = B + ((size_t)b * 1024 + pn * 256) * 1024; }
        return true;
    }
    __device__ __forceinline__ unsigned rowoff(const Unit& u, int r) const { const int tok = r < u.aux1 ? rec[u.aux0 + r].x : 0; return (unsigned)tok * 2048u; }
};
struct EpiGU {
    bf16_t* act; const int4* rec;
    __device__ __forceinline__ void operator()(const f32x4 (&acc)[2][2][4][2], const Unit& u, int wr, int wc, int fr, int fq) const {
        const int slot = u.pn >> 1; const int colb = slot * 256 + (u.pn & 1) * 128 + wc * 32 + 8 * fq;
#pragma unroll
        for (int ai = 0; ai < 2; ++ai)
#pragma unroll
            for (int m = 0; m < 4; ++m) { const int r = ai * HALF + wr * 64 + m * 16 + fr;
                if (r < u.aux1) { const int4 rc = rec[u.aux0 + r]; const float rs = __int_as_float(rc.y), w = __int_as_float(slot ? rc.w : rc.z);
                    float v[8];
#pragma unroll
                    for (int n = 0; n < 2; ++n)
#pragma unroll
                        for (int e = 0; e < 4; ++e) { const float g = acc[ai][0][m][n][e] * rs, up = acc[ai][1][m][n][e] * rs; v[4 * n + e] = g / (1.0f + __expf(-g)) * up * w; }
                    u32x4 o; o.x = cvt_pk_bf16(v[0], v[1]); o.y = cvt_pk_bf16(v[2], v[3]); o.z = cvt_pk_bf16(v[4], v[5]); o.w = cvt_pk_bf16(v[6], v[7]);
                    *(u32x4*)(act + ((size_t)u.pm * 256 + r) * 512 + colb) = o; }
                asm volatile("" ::: "memory"); }
    }
};
struct EpiDown {
    float* xio; bf16_t* xb; float* rowss; const int4* rec;
    __device__ __forceinline__ void operator()(const f32x4 (&acc)[2][2][4][2], const Unit& u, int wr, int wc, int fr, int fq) const {
        const int col0 = u.pn * BM + wc * 32 + 8 * fq;
#pragma unroll
        for (int ai = 0; ai < 2; ++ai)
#pragma unroll
            for (int m = 0; m < 4; ++m) { const int r = ai * HALF + wr * 64 + m * 16 + fr; const bool valid = r < u.aux1;
                float ss = 0.f; int tok = 0;
                if (valid) { tok = rec[u.aux0 + r].x; const size_t ro = (size_t)tok * 1024 + col0;
#pragma unroll
                    for (int bj = 0; bj < 2; ++bj) {
                        const f32x4 r0 = *(const f32x4*)(xio + ro + bj * HALF), r1 = *(const f32x4*)(xio + ro + bj * HALF + 4);
                        const f32x4 v0 = acc[ai][bj][m][0] + r0, v1 = acc[ai][bj][m][1] + r1;
                        *(f32x4*)(xio + ro + bj * HALF) = v0; *(f32x4*)(xio + ro + bj * HALF + 4) = v1;
                        ss += v0[0] * v0[0] + v0[1] * v0[1] + v0[2] * v0[2] + v0[3] * v0[3] + v1[0] * v1[0] + v1[1] * v1[1] + v1[2] * v1[2] + v1[3] * v1[3];
                        u32x4 w; w.x = cvt_pk_bf16(v0[0], v0[1]); w.y = cvt_pk_bf16(v0[2], v0[3]); w.z = cvt_pk_bf16(v1[0], v1[1]); w.w = cvt_pk_bf16(v1[2], v1[3]);
                        *(u32x4*)(xb + ro + bj * HALF) = w; } }
                ss += __shfl_xor(ss, 16); ss += __shfl_xor(ss, 32);
                if (valid && fq == 0) atomicAdd(rowss + tok, ss);
                asm volatile("" ::: "memory"); }
    }
};
}

__device__ __forceinline__ void phase_final(const Args& a) {
    float* x = a.out; const float* fw = a.in[20]; const float* rowss = (const float*)(a.ws + WS_ROWSS) + NTOK;
    const int lane = threadIdx.x & 63, wave = threadIdx.x >> 6;
    for (int m = blockIdx.x * NWAVES + wave; m < NTOK; m += gridDim.x * NWAVES) {
        const float rs = rsqrtf(rowss[m] * (1.0f / D_MODEL) + 1e-6f);
        float4* xr = (float4*)(x + (size_t)m * D_MODEL) + lane;
#pragma unroll
        for (int j = 0; j < 4; ++j) { float4 v = xr[64 * j]; const float4 w = ((const float4*)fw)[lane + 64 * j]; v.x *= rs * w.x; v.y *= rs * w.y; v.z *= rs * w.z; v.w *= rs * w.w; xr[64 * j] = v; }
    }
}

__device__ __forceinline__ void phase_ret_simple(const Args& a, LAS unsigned char* lds) {
    unsigned char* ws = a.ws;
    const int item = blockIdx.x; if (item >= 32) return;
    const int bh = item >> 1, cgp = item & 1, b = bh >> 2, h = bh & 3;
    const int t = threadIdx.x, half = t >> 8, cl = t & 255, col = cgp * 256 + cl;
    const bf16_t* Pq = (const bf16_t*)(ws + WS_PQ); const bf16_t* Pk = (const bf16_t*)(ws + WS_PK); bf16_t* Pv = (bf16_t*)(ws + WS_PV);
    LAS float* qk = (LAS float*)lds;
    LAS float* red = qk + 512;
    const float gamma = 1.0f - exp2f(-5.0f - (float)h);
    const int e = t & 255, p = e >> 1, odd = e & 1;
    const float inv = 1.0f / powf(10000.0f, (float)p / 127.0f);
    const bf16_t* src = (t < 256 ? Pq : Pk) + h * 256 + 2 * p;
    const float osc = t < 256 ? 1.0f : 0.0625f;
    float S[128];
#pragma unroll
    for (int i = 0; i < 128; ++i) S[i] = 0.f;
    for (int tt = 0; tt < SEQ; ++tt) {
        const size_t tok = (size_t)b * SEQ + tt;
        { const unsigned w = *(const unsigned*)(src + tok * 1024); const float x1 = __uint_as_float(w << 16), x2 = __uint_as_float(w & 0xffff0000u);
          float sn, cs; sincosf((float)tt * inv, &sn, &cs);
          qk[t] = (odd ? (x1 * sn + x2 * cs) : (x1 * cs - x2 * sn)) * osc; }
        const float v = bf2f(Pv[tok * 2048 + h * 512 + col]);
        __syncthreads();
        float oo = 0.f;
#pragma unroll
        for (int i0 = 0; i0 < 128; i0 += 16) {
#pragma unroll
            for (int i = i0; i < i0 + 16; ++i) { S[i] = fmaf(gamma, S[i], qk[256 + half * 128 + i] * v); oo = fmaf(qk[half * 128 + i], S[i], oo); }
            asm volatile("" ::: "memory"); }
        if (half == 1) red[cl] = oo;
        __syncthreads();
        if (half == 0) Pv[tok * 2048 + h * 512 + col] = (bf16_t)(g8::cvt_pk_bf16(oo + red[cl], 0.f) & 0xffffu);
    }
}

__device__ __forceinline__ void phase_post1(const Args& a) {
    unsigned char* ws = a.ws;
    bf16_t* O = (bf16_t*)(ws + WS_PV); const bf16_t* G = (const bf16_t*)(ws + WS_PG);
    const float* nw = a.in[12];
    const int lane = threadIdx.x & 63, wave = threadIdx.x >> 6;
    for (int m = blockIdx.x * NWAVES + wave; m < NTOK; m += gridDim.x * NWAVES) {
        float v[32], z[32]; float s = 0.f;
#pragma unroll
        for (int q = 0; q < 4; ++q) {
            const u32x4 o = *((const u32x4*)(O + (size_t)m * 2048 + 32 * lane) + q); const u32x4 zz = *((const u32x4*)(G + (size_t)m * 2048 + 32 * lane) + q);
            const unsigned ow[4] = {o.x, o.y, o.z, o.w}; const unsigned zw[4] = {zz.x, zz.y, zz.z, zz.w};
#pragma unroll
            for (int i = 0; i < 4; ++i) { v[8 * q + 2 * i] = __uint_as_float(ow[i] << 16); v[8 * q + 2 * i + 1] = __uint_as_float(ow[i] & 0xffff0000u);
                z[8 * q + 2 * i] = __uint_as_float(zw[i] << 16); z[8 * q + 2 * i + 1] = __uint_as_float(zw[i] & 0xffff0000u); }
        }
#pragma unroll
        for (int i = 0; i < 32; ++i) s += v[i] * v[i];
        s += __shfl_xor(s, 1); s += __shfl_xor(s, 2); s += __shfl_xor(s, 4); s += __shfl_xor(s, 8);
        const float rs = rsqrtf(s * (1.f / 512.f) + 1e-6f);
#pragma unroll
        for (int q = 0; q < 4; ++q) {
            unsigned r[4];
#pragma unroll
            for (int i = 0; i < 4; ++i) { const int j = 8 * q + 2 * i; const int c0 = (32 * lane + j) & 511;
                r[i] = g8::cvt_pk_bf16(v[j] * rs * nw[c0] * siluf_(z[j]), v[j + 1] * rs * nw[c0 + 1] * siluf_(z[j + 1])); }
            *((u32x4*)(O + (size_t)m * 2048 + 32 * lane) + q) = (u32x4){r[0], r[1], r[2], r[3]};
        }
    }
}

__global__ void __launch_bounds__(NTHREADS, 2) mega(Args a) {
    extern __shared__ __attribute__((aligned(16))) unsigned char lds_raw[];
    LAS unsigned char* lds = (LAS unsigned char*)lds_raw;
    cg::grid_group grid = cg::this_grid();
    unsigned char* ws = a.ws;
    const int G = gridDim.x, c = blockIdx.x;

    phase_prep(a, lds);
    grid.sync();
    {
        g8::DenseOrder S{(const char*)(ws + WS_XB), (const char*)(ws + WS_WIN0), 2048, 2048, NTOK / 256, 16, G, c};
        g8::EpiGroups E{(bf16_t*)(ws + WS_P), (const float*)(ws + WS_RS), 2, 512, GRP0 / 2};
        g8::gemm_phase<g8::EpiGroups, g8::DenseOrder>(lds, 2048, 2048, 1024, S, E);
    }
    grid.sync();
    phase_mix0_simple(a, lds);
    grid.sync();
    phase_post0(a);
    moe_weight_items(a, 0, lds);
    grid.sync();
    {
        g8::DenseOrder S{(const char*)(ws + WS_O0), (const char*)(ws + WS_WOUT0), 2048, 2048, NTOK / 256, 4, G, c};
        g8::EpiRes E{a.in[0], a.out, (bf16_t*)(ws + WS_XB)};
        g8::gemm_phase<g8::EpiRes, g8::DenseOrder>(lds, 2048, 2048, 1024, S, E);
    }
    grid.sync();
#define MOE_LAYER(layer) do { \
    phase_route(a, layer, lds); \
    grid.sync(); \
    moe_table(a, layer, lds); \
    {   g8::MoeOrder S{(const char*)(ws + WS_XB), (const char*)(ws + WS_WGU), (const int4*)(ws + WS_ROWREC), (LAS const int*)(lds + LDS_TAB), 0, G, c}; \
        g8::EpiGU E{(bf16_t*)(ws + WS_ACT), (const int4*)(ws + WS_ROWREC)}; \
        g8::gemm_phase<g8::EpiGU, g8::MoeOrder, true>(lds, 2048, 2048, 1024, S, E); } \
    grid.sync(); \
    {   g8::MoeOrder S{(const char*)(ws + WS_ACT), (const char*)(ws + WS_WDN), (const int4*)(ws + WS_ROWREC), (LAS const int*)(lds + LDS_TAB), 1, G, c}; \
        g8::EpiDown E{a.out, (bf16_t*)(ws + WS_XB), (float*)(ws + WS_ROWSS) + (layer) * NTOK, (const int4*)(ws + WS_ROWREC)}; \
        g8::gemm_phase<g8::EpiDown, g8::MoeOrder, false>(lds, 1024, 1024, 512, S, E); } \
    grid.sync(); } while (0)
    MOE_LAYER(0);
    {
        g8::DenseOrder S{(const char*)(ws + WS_XB), (const char*)(ws + WS_WIN1), 2048, 2048, NTOK / 256, 24, G, c};
        g8::EpiOdd E{(bf16_t*)(ws + WS_PQ), (bf16_t*)(ws + WS_PK), (bf16_t*)(ws + WS_PV), (bf16_t*)(ws + WS_PG), (const float*)(ws + WS_ROWSS)};
        g8::gemm_phase<g8::EpiOdd, g8::DenseOrder>(lds, 2048, 2048, 1024, S, E);
    }
    grid.sync();
    phase_ret_simple(a, lds);
    grid.sync();
    phase_post1(a);
    moe_weight_items(a, 1, lds);
    grid.sync();
    {
        g8::DenseOrder S{(const char*)(ws + WS_PV), (const char*)(ws + WS_WOUT1), 4096, 4096, NTOK / 256, 4, G, c};
        g8::EpiRes E{a.out, a.out, (bf16_t*)(ws + WS_XB)};
        g8::gemm_phase<g8::EpiRes, g8::DenseOrder>(lds, 4096, 4096, 2048, S, E);
    }
    grid.sync();
    MOE_LAYER(1);
    phase_final(a);
}

extern "C" void kernel_launch(void* const* d_in, const int* in_sizes, int n_in, void* d_out, int out_size, void* d_ws, size_t ws_size, hipStream_t stream) {
    static int grid_blocks = 0;
    if (!grid_blocks) {
        if (ws_size < WS_END || n_in != 21) { fprintf(stderr, "kernel_launch: ws %zu < %zu or n_in %d\n", ws_size, (size_t)WS_END, n_in); grid_blocks = -1; return; }
        int dev = 0, cus = 0, per_cu = 0;
        (void)hipGetDevice(&dev);
        (void)hipDeviceGetAttribute(&cus, hipDeviceAttributeMultiprocessorCount, dev);
        (void)hipFuncSetAttribute((const void*)mega, hipFuncAttributeMaxDynamicSharedMemorySize, LDS_BYTES);
        (void)hipOccupancyMaxActiveBlocksPerMultiprocessor(&per_cu, (const void*)mega, NTHREADS, LDS_BYTES);
        if (per_cu < 1) { fprintf(stderr, "kernel_launch: occupancy query says %d blocks per CU\n", per_cu); grid_blocks = -1; return; }
        grid_blocks = cus;
    }
    if (grid_blocks < 0) return;
    Args a{};
    for (int i = 0; i < 21; ++i) a.in[i] = (const float*)d_in[i];
    a.out = (float*)d_out; a.ws = (unsigned char*)d_ws;
    void* args[] = {&a};
    hipError_t e = hipLaunchCooperativeKernel((const void*)mega, dim3(grid_blocks), dim3(NTHREADS), args, LDS_BYTES, stream);
    if (e != hipSuccess) fprintf(stderr, "cooperative launch failed: %s (grid %d)\n", hipGetErrorString(e), grid_blocks);
}
```

```cpp
#include <hip/hip_runtime.h>
#include <hip/hip_cooperative_groups.h>
#include <cstdint>
#include <cstdio>
namespace cg = cooperative_groups;

#define D_MODEL 1024
#define BATCH 4
#define SEQ 4096
#define NTOK (BATCH * SEQ)
#define EVEN_IN 4104
#define ODD_IN 6144
#define NTHREADS 512
#define NWAVES 8

__device__ __forceinline__ float sigmoidf_(float x) { return 1.0f / (1.0f + __expf(-x)); }
__device__ __forceinline__ float siluf_(float x) { return x / (1.0f + __expf(-x)); }
__device__ __forceinline__ float softplusf_(float x) { return x > 20.f ? x : log1pf(__expf(x)); }
__device__ __forceinline__ float bf2f(unsigned short b) { return __uint_as_float(((unsigned)b) << 16); }
__device__ __forceinline__ float wave_sum(float v) { for (int o = 32; o > 0; o >>= 1) v += __shfl_xor(v, o); return v; }

namespace g8 {
#define G8_LAS __attribute__((address_space(3)))
typedef unsigned short bf16_t;
typedef short bf16x8 __attribute__((ext_vector_type(8)));
typedef float f32x4 __attribute__((ext_vector_type(4)));
typedef unsigned u32x4 __attribute__((ext_vector_type(4)));
typedef unsigned u32x2 __attribute__((ext_vector_type(2)));
constexpr int BM = 256, BK = 64, HALF = 128, HTB = HALF * BK * 2, STAGE_BYTES = 8 * HTB;

__host__ __device__ __forceinline__ int lds_byte(int r, int c) { const int st = (r >> 4) * 2 + (c >> 5), rr = r & 15, cc = c & 31, ob = rr * 64 + cc * 2; return st * 1024 + (ob ^ (((ob >> 9) & 1) << 5)); }
__host__ __device__ __forceinline__ void stage_rc(int b, int& R, int& C) { const int st = b / 1024, sb = b % 1024, swz = sb ^ (((sb >> 9) & 1) << 5); R = (st >> 1) * 16 + swz / 64; C = (st & 1) * 32 + (swz % 64) / 2; }
__host__ __device__ __forceinline__ int perm32(int rho) { const int n = rho >> 4, i = rho & 15; return 8 * (i >> 2) + 4 * n + (i & 3); }
typedef float cvt_f2 __attribute__((ext_vector_type(2)));
typedef __bf16 cvt_b2 __attribute__((ext_vector_type(2)));
__device__ __forceinline__ unsigned cvt_pk_bf16(float lo, float hi) { const cvt_f2 v = {lo, hi}; return __builtin_bit_cast(unsigned, __builtin_convertvector(v, cvt_b2)); }

struct Unit { const char* a; const char* b; int pm, pn, aux0, aux1; };

template <class Epi, class Sched, bool GATHER = false>
__device__ __forceinline__ void gemm_phase(G8_LAS unsigned char* lds, const int lda, const int ldb, const int K, const Sched& S, const Epi& E) {
    const int tid = threadIdx.x, wid = __builtin_amdgcn_readfirstlane(tid >> 6), lane = tid & 63, wr = wid >> 2, wc = wid & 3, fr = lane & 15, fq = lane >> 4;
    const int nt = K / BK;
    unsigned voffB[2];
#pragma unroll
    for (int i = 0; i < 2; ++i) { int R, C; stage_rc(tid * 16 + i * 8192, R, C); const int Rb = (R & ~31) + perm32(R & 31);
        voffB[i] = (unsigned)(Rb * ldb + C * 2); }
    unsigned vA[2][2], vAn[2][2];
    const size_t kstep = (size_t)(BK * 2);
    const size_t hstepB = (size_t)HALF * ldb;
    const unsigned ldsw = (unsigned)wid * 1024u;
    const int aoff = lds_byte(wr * 64 + fr, fq * 8), boff = lds_byte(wc * 32 + fr, fq * 8);
#define G8_SA(b, h) (((b) * 2 + (h)) * HTB)
#define G8_SB(b, h) ((4 + (b) * 2 + (h)) * HTB)
#define G8_STAGE(bufoff, gbase, voff) do { _Pragma("unroll") for (int _i = 0; _i < 2; ++_i) \
        __builtin_amdgcn_global_load_lds((const unsigned*)((const char*)(gbase) + (voff)[_i]), (G8_LAS unsigned*)(lds + (bufoff) + ldsw + _i * 8192), 16, 0, 0); } while (0)
#define G8_SETV(V, u) do { int _t = tid; asm volatile("" : "+v"(_t)); _Pragma("unroll") for (int _i = 0; _i < 2; ++_i) { int _R, _C; stage_rc(_t * 16 + _i * 8192, _R, _C); \
        _Pragma("unroll") for (int _h = 0; _h < 2; ++_h) V[_h][_i] = (GATHER ? S.rowoff(u, _h * HALF + _R) : (unsigned)((_h * HALF + _R) * lda)) + (unsigned)(_C * 2); } } while (0)
#define G8_LDA(dst, b, h) do { _Pragma("unroll") for (int m = 0; m < 4; ++m) _Pragma("unroll") for (int k = 0; k < 2; ++k) dst[m][k] = *(const G8_LAS bf16x8*)(lds + G8_SA(b, h) + aoff + m * 2048 + k * 1024); } while (0)
#define G8_LDB(dst, b, h) do { _Pragma("unroll") for (int n = 0; n < 2; ++n) _Pragma("unroll") for (int k = 0; k < 2; ++k) dst[n][k] = *(const G8_LAS bf16x8*)(lds + G8_SB(b, h) + boff + n * 2048 + k * 1024); } while (0)
#define G8_MMA(ai, bj, At, Bt) do { __builtin_amdgcn_s_setprio(1); _Pragma("unroll") for (int m = 0; m < 4; ++m) _Pragma("unroll") for (int n = 0; n < 2; ++n) _Pragma("unroll") for (int k = 0; k < 2; ++k) \
        acc[ai][bj][m][n] = __builtin_amdgcn_mfma_f32_16x16x32_bf16(Bt[n][k], At[m][k], acc[ai][bj][m][n], 0, 0, 0); __builtin_amdgcn_s_setprio(0); } while (0)
#define G8_WAIT_V(n) asm volatile("s_waitcnt vmcnt(" #n ")" ::: "memory")
#define G8_WAIT_L(n) asm volatile("s_waitcnt lgkmcnt(" #n ")" ::: "memory")
#define G8_BAR __builtin_amdgcn_s_barrier()
#define G8_SCHED __builtin_amdgcn_sched_barrier(0)
    Unit cur, nxt; int ui = 0;
    if (!S.next(0, cur)) return;
    f32x4 acc[2][2][4][2];
#pragma unroll
    for (int a = 0; a < 2; ++a)
#pragma unroll
        for (int b = 0; b < 2; ++b)
#pragma unroll
            for (int m = 0; m < 4; ++m)
#pragma unroll
                for (int n = 0; n < 2; ++n) acc[a][b][m][n] = (f32x4){0.f, 0.f, 0.f, 0.f};
    bf16x8 At[4][2], B0[2][2], B1[2][2];
    const char* cA = cur.a; const char* cB = cur.b;
    G8_SETV(vA, cur);
    if (GATHER) asm volatile("s_waitcnt vmcnt(0)" ::: "memory");
    G8_STAGE(G8_SB(0, 0), cB, voffB); G8_STAGE(G8_SA(0, 0), cA, vA[0]); G8_STAGE(G8_SB(0, 1), cB + hstepB, voffB); G8_STAGE(G8_SA(0, 1), cA, vA[1]);
    if (wr == 1) G8_BAR;
    G8_WAIT_V(4); G8_BAR;
    G8_STAGE(G8_SB(1, 0), cB + kstep, voffB); G8_STAGE(G8_SA(1, 0), cA + kstep, vA[0]); G8_STAGE(G8_SB(1, 1), cB + hstepB + kstep, voffB);
    G8_WAIT_V(6); G8_BAR;
    for (;;) {
        const bool has_next = S.next(ui + 1, nxt);
        const char* nA = has_next ? nxt.a : cA; const char* nB = has_next ? nxt.b : cB;
        if (GATHER && has_next) { G8_SETV(vAn, nxt); }
        else {
#pragma unroll
            for (int _h = 0; _h < 2; ++_h)
#pragma unroll
                for (int _i = 0; _i < 2; ++_i) vAn[_h][_i] = vA[_h][_i]; }
        for (int t = 0; t < nt; t += 2) {
            const bool last = (t == nt - 2);
            const char* a1 = cA + (size_t)(t + 1) * kstep;
            const char* a2 = last ? nA : cA + (size_t)(t + 2) * kstep; const char* b2 = last ? nB : cB + (size_t)(t + 2) * kstep;
            const char* a3 = a2 + kstep; const char* b3 = b2 + kstep;
            unsigned o2[2][2];
#pragma unroll
            for (int _h = 0; _h < 2; ++_h)
#pragma unroll
                for (int _i = 0; _i < 2; ++_i) o2[_h][_i] = (GATHER && last) ? vAn[_h][_i] : vA[_h][_i];
            G8_LDB(B0, 0, 0); G8_SCHED; G8_LDA(At, 0, 0); G8_STAGE(G8_SA(1, 1), a1, vA[1]);
            G8_WAIT_L(8); G8_BAR; G8_WAIT_L(0); G8_MMA(0, 0, At, B0); G8_BAR; G8_SCHED;
            G8_LDB(B1, 0, 1); G8_STAGE(G8_SB(0, 0), b2, voffB);
            G8_BAR; G8_WAIT_L(0); G8_MMA(0, 1, At, B1); G8_BAR;
            G8_LDA(At, 0, 1); G8_STAGE(G8_SA(0, 0), a2, o2[0]);
            G8_BAR; G8_WAIT_L(0); G8_MMA(1, 0, At, B0); G8_BAR; G8_SCHED;
            G8_STAGE(G8_SB(0, 1), b2 + hstepB, voffB);
            G8_WAIT_V(6); G8_BAR; G8_MMA(1, 1, At, B1); G8_BAR;
            G8_LDB(B0, 1, 0); G8_SCHED; G8_LDA(At, 1, 0); G8_STAGE(G8_SA(0, 1), a2, o2[1]);
            G8_WAIT_L(8); G8_BAR; G8_WAIT_L(0); G8_MMA(0, 0, At, B0); G8_BAR; G8_SCHED;
            G8_LDB(B1, 1, 1); G8_STAGE(G8_SB(1, 0), b3, voffB);
            G8_BAR; G8_WAIT_L(0); G8_MMA(0, 1, At, B1); G8_BAR;
            G8_LDA(At, 1, 1); G8_STAGE(G8_SA(1, 0), a3, o2[0]);
            G8_BAR; G8_WAIT_L(0); G8_MMA(1, 0, At, B0); G8_BAR; G8_SCHED;
            G8_STAGE(G8_SB(1, 1), b3 + hstepB, voffB);
            G8_WAIT_V(6); G8_BAR; G8_MMA(1, 1, At, B1); G8_BAR;
        }
        { int fr_ = fr, fq_ = fq; asm volatile("" : "+v"(fr_), "+v"(fq_)); E(acc, cur, wr, wc, fr_, fq_); }
        if (!has_next) break;
#pragma unroll
        for (int a = 0; a < 2; ++a)
#pragma unroll
            for (int b = 0; b < 2; ++b)
#pragma unroll
                for (int m = 0; m < 4; ++m)
#pragma unroll
                    for (int n = 0; n < 2; ++n) acc[a][b][m][n] = (f32x4){0.f, 0.f, 0.f, 0.f};
        cur = nxt; cA = nA; cB = nB; ++ui;
#pragma unroll
        for (int _h = 0; _h < 2; ++_h)
#pragma unroll
            for (int _i = 0; _i < 2; ++_i) vA[_h][_i] = vAn[_h][_i];
    }
    G8_WAIT_V(0);
    if (wr == 0) G8_BAR;
    G8_BAR;
#undef G8_SA
#undef G8_SB
#undef G8_STAGE
#undef G8_SETV
#undef G8_LDA
#undef G8_LDB
#undef G8_MMA
#undef G8_WAIT_V
#undef G8_WAIT_L
#undef G8_BAR
#undef G8_SCHED
}


struct DenseOrder {
    const char* A; const char* B; int lda, ldb, nM, nN, G, c;
    __device__ __forceinline__ bool next(int i, Unit& u) const {
        const int L = i * G + c; if (L >= nM * nN) return false;
        const int grp = L / (8 * nN), rem = L % (8 * nN); const int gsz = (nM - grp * 8) < 8 ? (nM - grp * 8) : 8;
        u.pm = grp * 8 + rem % gsz; u.pn = rem / gsz;
        u.a = A + (size_t)u.pm * BM * lda; u.b = B + (size_t)u.pn * BM * ldb; u.aux0 = 0; u.aux1 = 0; return true;
    }
    __device__ __forceinline__ unsigned rowoff(const Unit&, int) const { return 0u; }
};

struct EpiGroups {
    bf16_t* dst; const float* rs; int upg; int ld; size_t gstride;
    __device__ __forceinline__ void operator()(const f32x4 (&acc)[2][2][4][2], const Unit& u, int wr, int wc, int fr, int fq) const {
        const int row0 = u.pm * BM + wr * 64 + fr;
        bf16_t* base = dst + (size_t)(u.pn / upg) * gstride + (u.pn % upg) * 256 + wc * 32 + 8 * fq;
#pragma unroll
        for (int ai = 0; ai < 2; ++ai)
#pragma unroll
            for (int m = 0; m < 4; ++m) { const int row = row0 + ai * HALF + m * 16; const float sc = rs[row]; bf16_t* rowp = base + (size_t)row * ld;
#pragma unroll
                for (int bj = 0; bj < 2; ++bj) { const f32x4 v0 = acc[ai][bj][m][0] * sc, v1 = acc[ai][bj][m][1] * sc;
                    u32x4 w; w.x = cvt_pk_bf16(v0[0], v0[1]); w.y = cvt_pk_bf16(v0[2], v0[3]); w.z = cvt_pk_bf16(v1[0], v1[1]); w.w = cvt_pk_bf16(v1[2], v1[3]);
                    *(u32x4*)(rowp + bj * HALF) = w; } }
    }
};
struct EpiOdd {
    bf16_t* pq; bf16_t* pk; bf16_t* pv; bf16_t* pg; const float* rowss;
    __device__ __forceinline__ void operator()(const f32x4 (&acc)[2][2][4][2], const Unit& u, int wr, int wc, int fr, int fq) const {
        const int row0 = u.pm * BM + wr * 64 + fr;
        bf16_t* base; int ld, ct; const bool blocked = u.pn < 8;
        if (u.pn < 4) { base = pq; ld = 1024; ct = u.pn; } else if (u.pn < 8) { base = pk; ld = 1024; ct = u.pn - 4; }
        else if (u.pn < 16) { base = pv; ld = 2048; ct = u.pn - 8; } else { base = pg; ld = 2048; ct = u.pn - 16; }
        base += (blocked ? 0 : ct * 256) + wc * 32 + 8 * fq;
#pragma unroll
        for (int ai = 0; ai < 2; ++ai)
#pragma unroll
            for (int m = 0; m < 4; ++m) { const int row = row0 + ai * HALF + m * 16; const float sc = rsqrtf(rowss[row] * (1.0f / 1024.0f) + 1e-6f);
                bf16_t* rowp = blocked ? base + ((size_t)(((row >> 12) * 4 + ct) * 64 + ((row & 4095) >> 6)) * 64 + (row & 63)) * 256 : base + (size_t)row * ld;
#pragma unroll
                for (int bj = 0; bj < 2; ++bj) { const f32x4 v0 = acc[ai][bj][m][0] * sc, v1 = acc[ai][bj][m][1] * sc;
                    u32x4 w; w.x = cvt_pk_bf16(v0[0], v0[1]); w.y = cvt_pk_bf16(v0[2], v0[3]); w.z = cvt_pk_bf16(v1[0], v1[1]); w.w = cvt_pk_bf16(v1[2], v1[3]);
                    *(u32x4*)(rowp + bj * HALF) = w; } }
    }
};
struct EpiRes {
    const float* xin; float* xout; bf16_t* xb;
    __device__ __forceinline__ void operator()(const f32x4 (&acc)[2][2][4][2], const Unit& u, int wr, int wc, int fr, int fq) const {
        const int row0 = u.pm * BM + wr * 64 + fr; const int col0 = u.pn * BM + wc * 32 + 8 * fq;
#pragma unroll
        for (int ai = 0; ai < 2; ++ai)
#pragma unroll
            for (int m = 0; m < 4; ++m) { const size_t ro = (size_t)(row0 + ai * HALF + m * 16) * 1024 + col0;
#pragma unroll
                for (int bj = 0; bj < 2; ++bj) {
                    const f32x4 r0 = *(const f32x4*)(xin + ro + bj * HALF), r1 = *(const f32x4*)(xin + ro + bj * HALF + 4);
                    const f32x4 v0 = acc[ai][bj][m][0] + r0, v1 = acc[ai][bj][m][1] + r1;
                    *(f32x4*)(xout + ro + bj * HALF) = v0; *(f32x4*)(xout + ro + bj * HALF + 4) = v1;
                    u32x4 w; w.x = cvt_pk_bf16(v0[0], v0[1]); w.y = cvt_pk_bf16(v0[2], v0[3]); w.z = cvt_pk_bf16(v1[0], v1[1]); w.w = cvt_pk_bf16(v1[2], v1[3]);
                    *(u32x4*)(xb + ro + bj * HALF) = w; } }
    }
};
}
typedef g8::bf16_t bf16_t;
typedef g8::u32x4 u32x4;
typedef g8::u32x2 u32x2;
#define LAS __attribute__((address_space(3)))

constexpr size_t MiB = (size_t)1 << 20;
constexpr size_t WS_RS = 64 * 1024;
constexpr size_t WS_GATES = 128 * 1024;
constexpr size_t WS_XB = 4 * MiB;
constexpr size_t WS_WIN0 = 36 * MiB;
constexpr size_t WS_WOUT0 = 44 * MiB;
constexpr size_t WS_WIN1 = 46 * MiB;
constexpr size_t WS_WOUT1 = 58 * MiB;
constexpr size_t WS_P = 62 * MiB;
constexpr size_t GRP0 = 16 * MiB;
constexpr size_t WS_O0 = WS_P + 8 * GRP0;
constexpr size_t WS_PQ = WS_P, WS_PK = WS_P + 32 * MiB, WS_PV = WS_P + 64 * MiB, WS_PG = WS_P + 128 * MiB;
constexpr size_t WS_END = WS_P + 192 * MiB;
constexpr size_t WS_CNT = 1024;
constexpr size_t WS_ROWSS = 1 * MiB;
constexpr size_t WS_ROWREC = WS_WIN0;
constexpr size_t WS_WGU = WS_P;
constexpr size_t WS_WDN = WS_P + 16 * MiB;
constexpr size_t WS_ACT = WS_P + 40 * MiB;
constexpr int LDS_TAB = g8::STAGE_BYTES;
constexpr int LDS_BYTES = g8::STAGE_BYTES + 1024;

struct Args { const float* in[21]; float* out; unsigned char* ws; };

__device__ __forceinline__ void conv_tile(const float* __restrict__ W, int ldw, int srccol0, const float* __restrict__ scale, bf16_t* __restrict__ Wt, int K, int k0, int n0, LAS float* tile, int ks0 = -1) {
    if (ks0 < 0) ks0 = k0;
    const int t = threadIdx.x;
    for (int i = t; i < 64 * 64; i += NTHREADS) { const int kk = i >> 6, nn = i & 63; float v = W[(size_t)(ks0 + kk) * ldw + srccol0 + nn]; if (scale) v *= scale[ks0 + kk]; tile[kk * 65 + nn] = v; }
    __syncthreads();
    { const int nn = t >> 3, kc = t & 7;
      u32x4 o; o.x = g8::cvt_pk_bf16(tile[(kc * 8 + 0) * 65 + nn], tile[(kc * 8 + 1) * 65 + nn]); o.y = g8::cvt_pk_bf16(tile[(kc * 8 + 2) * 65 + nn], tile[(kc * 8 + 3) * 65 + nn]);
      o.z = g8::cvt_pk_bf16(tile[(kc * 8 + 4) * 65 + nn], tile[(kc * 8 + 5) * 65 + nn]); o.w = g8::cvt_pk_bf16(tile[(kc * 8 + 6) * 65 + nn], tile[(kc * 8 + 7) * 65 + nn]);
      *(u32x4*)(Wt + (size_t)(n0 + nn) * K + k0 + kc * 8) = o; }
    __syncthreads();
}

__device__ __forceinline__ void phase_prep(const Args& a, LAS unsigned char* lds) {
    const float* x = a.in[0]; const float* nmw = a.in[1];
    const float* w_in0 = a.in[3]; const float* a_log = a.in[5]; const float* dt_bias = a.in[6];
    unsigned char* ws = a.ws;
    LAS float* Wg8 = (LAS float*)lds;
    LAS float* tile = (LAS float*)(lds + 32768);
    const int tid = threadIdx.x, lane = tid & 63, wave = tid >> 6;
    for (int i = tid; i < 1024 * 8; i += NTHREADS) { const int k = i >> 3, j = i & 7; Wg8[i] = w_in0[(size_t)k * EVEN_IN + 2048 + j] * nmw[k]; }
    __syncthreads();
    float* RS = (float*)(ws + WS_RS); float* GATES = (float*)(ws + WS_GATES); bf16_t* XB = (bf16_t*)(ws + WS_XB);
    for (int m = blockIdx.x * NWAVES + wave; m < NTOK; m += gridDim.x * NWAVES) {
        const float4* xr = (const float4*)(x + (size_t)m * D_MODEL) + lane;
        float4 v[4]; float s = 0.f;
#pragma unroll
        for (int j = 0; j < 4; ++j) { v[j] = xr[64 * j]; s += v[j].x * v[j].x + v[j].y * v[j].y + v[j].z * v[j].z + v[j].w * v[j].w; }
        s = wave_sum(s);
        const float rs = rsqrtf(s * (1.0f / D_MODEL) + 1e-6f);
        float g[8];
#pragma unroll
        for (int q = 0; q < 8; ++q) g[q] = 0.f;
#pragma unroll
        for (int j = 0; j < 4; ++j) {
            const float xv[4] = {v[j].x, v[j].y, v[j].z, v[j].w};
#pragma unroll
            for (int e = 0; e < 4; ++e) { const int k = 256 * j + 4 * lane + e;
#pragma unroll
                for (int q = 0; q < 8; ++q) g[q] = fmaf(xv[e], Wg8[k * 8 + q], g[q]); }
            u32x2 o; o.x = g8::cvt_pk_bf16(v[j].x, v[j].y); o.y = g8::cvt_pk_bf16(v[j].z, v[j].w);
            *((u32x2*)(XB + (size_t)m * D_MODEL) + lane + 64 * j) = o;
        }
#pragma unroll
        for (int q = 0; q < 8; ++q) g[q] = wave_sum(g[q]) * rs;
        if (lane == 0) {
            RS[m] = rs;
#pragma unroll
            for (int h = 0; h < 4; ++h) { GATES[(size_t)m * 8 + h] = sigmoidf_(g[h]); GATES[(size_t)m * 8 + 4 + h] = -__expf(a_log[h]) * softplusf_(g[4 + h] + dt_bias[h]); }
        }
    }
    for (int i = blockIdx.x * NTHREADS + tid; i < 2 * NTOK; i += gridDim.x * NTHREADS) ((float*)(ws + WS_ROWSS))[i] = 0.f;
    if (blockIdx.x == 0 && tid < 64) ((int*)(ws + WS_CNT))[tid] = 0;
    constexpr int I0 = 16 * 64, I1 = 16 * 16, I2 = 16 * 96, I3 = 32 * 16;
    for (int it = blockIdx.x; it < I0 + I1 + I2 + I3; it += gridDim.x) {
        int r = it;
        if (r < I0) { const int k0 = (r / 64) * 64, n0 = (r % 64) * 64; conv_tile(w_in0, EVEN_IN, n0 + (n0 >= 2048 ? 8 : 0), nmw, (bf16_t*)(ws + WS_WIN0), 1024, k0, n0, tile); continue; } r -= I0;
        if (r < I1) { const int k0 = (r / 16) * 64, n0 = (r % 16) * 64; conv_tile(a.in[10], 1024, n0, nullptr, (bf16_t*)(ws + WS_WOUT0), 1024, k0, n0, tile); continue; } r -= I1;
        if (r < I2) { const int k0 = (r / 96) * 64, n0 = (r % 96) * 64; conv_tile(a.in[11], ODD_IN, n0, nmw + 1024, (bf16_t*)(ws + WS_WIN1), 1024, k0, n0, tile); continue; } r -= I2;
        { const int k0 = (r / 16) * 64, n0 = (r % 16) * 64; conv_tile(a.in[13], 1024, n0, nullptr, (bf16_t*)(ws + WS_WOUT1), 2048, k0, n0, tile); }
    }
}

__device__ __forceinline__ void phase_mix0_simple(const Args& a, LAS unsigned char* lds) {
    unsigned char* ws = a.ws;
    const int item = blockIdx.x; if (item >= 32) return;
    const int c = threadIdx.x; const bool act = c < 128; const int cc = c & 127;
    const int bh = item & 15, b = bh >> 2, h = bh & 3;
    LAS float* qs = (LAS float*)lds; LAS float* ks = qs + 128; LAS float* fs = ks + 128; LAS float* red = fs + 128;
    bf16_t* O = (bf16_t*)(ws + WS_O0);
    const float scale = 0.08838834764831845f;
    if (item < 16) {
        const bool act2 = c < 256; const int half = (c >> 7) & 1;
        LAS float* red2 = red + 8;
        float S[64];
#pragma unroll
        for (int i = 0; i < 64; ++i) S[i] = 0.f;
        const bf16_t* Gq = (const bf16_t*)(ws + WS_P); const bf16_t* Gk = (const bf16_t*)(ws + WS_P + GRP0); const bf16_t* Gv = (const bf16_t*)(ws + WS_P + 2 * GRP0);
        const float* GATES = (const float*)(ws + WS_GATES); const float* cw = a.in[4];
        float wq[4], wk[4], wv[4];
#pragma unroll
        for (int j = 0; j < 4; ++j) { wq[j] = cw[j * 1536 + h * 128 + cc]; wk[j] = cw[j * 1536 + 512 + h * 128 + cc]; wv[j] = cw[j * 1536 + 1024 + h * 128 + cc]; }
        float hq0 = 0.f, hq1 = 0.f, hq2 = 0.f, hk0 = 0.f, hk1 = 0.f, hk2 = 0.f, hv0 = 0.f, hv1 = 0.f, hv2 = 0.f;
        for (int t = 0; t < SEQ; ++t) {
            const size_t tok = (size_t)b * SEQ + t;
            float q = 0.f, k = 0.f, v = 0.f;
            if (act2) {
                const float xq = bf2f(Gq[tok * 512 + h * 128 + cc]), xk = bf2f(Gk[tok * 512 + h * 128 + cc]), xv = bf2f(Gv[tok * 512 + h * 128 + cc]);
                q = siluf_(hq0 * wq[0] + hq1 * wq[1] + hq2 * wq[2] + xq * wq[3]); hq0 = hq1; hq1 = hq2; hq2 = xq;
                k = siluf_(hk0 * wk[0] + hk1 * wk[1] + hk2 * wk[2] + xk * wk[3]); hk0 = hk1; hk1 = hk2; hk2 = xk;
                v = siluf_(hv0 * wv[0] + hv1 * wv[1] + hv2 * wv[2] + xv * wv[3]); hv0 = hv1; hv1 = hv2; hv2 = xv;
                const float sq = wave_sum(q * q), sk = wave_sum(k * k);
                if (c < 128 && (c & 63) == 0) { red[(c >> 6) * 2] = sq; red[(c >> 6) * 2 + 1] = sk; }
            }
            __syncthreads();
            if (act) { qs[cc] = q * rsqrtf(red[0] + red[2] + 1e-6f); ks[cc] = k * rsqrtf(red[1] + red[3] + 1e-6f); }
            __syncthreads();
            float be = 0.f, aa = 0.f;
            if (act2) {
                be = GATES[tok * 8 + h]; aa = __expf(GATES[tok * 8 + 4 + h]);
                float kd = 0.f;
#pragma unroll
                for (int i = 0; i < 64; ++i) { S[i] *= aa; kd = fmaf(ks[half * 64 + i], S[i], kd); }
                red2[c] = kd;
            }
            __syncthreads();
            float oo = 0.f;
            if (act2) {
                const float r = be * (v - (red2[cc] + red2[128 + cc]));
#pragma unroll
                for (int i = 0; i < 64; ++i) { S[i] = fmaf(ks[half * 64 + i], r, S[i]); oo = fmaf(qs[half * 64 + i], S[i], oo); }
            }
            __syncthreads();
            if (act2 && half == 1) red2[cc] = oo;
            __syncthreads();
            if (act) O[tok * 1024 + h * 128 + cc] = (bf16_t)(g8::cvt_pk_bf16((oo + red2[cc]) * scale, 0.f) & 0xffffu);
        }
    } else {
        const bf16_t* Hq = (const bf16_t*)(ws + WS_P + 4 * GRP0); const bf16_t* Hf = (const bf16_t*)(ws + WS_P + 5 * GRP0); const bf16_t* Hi = (const bf16_t*)(ws + WS_P + 6 * GRP0);
        const float* lbl = a.in[8];
        float S[128];
#pragma unroll
        for (int i = 0; i < 128; ++i) S[i] = 0.f;
        float lb;
        { const int ch = h * 128 + cc; const float l0 = lbl[ch], l1 = lbl[512 + ch], l2 = lbl[1024 + ch]; const float mx = fmaxf(l0, fmaxf(l1, l2));
          const float e0 = __expf(l0 - mx), e1 = __expf(l1 - mx), e2 = __expf(l2 - mx); lb = e0 / (e0 + e1 + e2); }
        for (int t = 0; t < SEQ; ++t) {
            const size_t tok = (size_t)b * SEQ + t;
            float iv = 0.f;
            if (act) {
                const float xq = bf2f(Hq[tok * 512 + h * 128 + cc]), xf = bf2f(Hf[tok * 512 + h * 128 + cc]); iv = bf2f(Hi[tok * 512 + h * 128 + cc]);
                const float f = lb + (1.f - lb) * sigmoidf_(xf);
                qs[cc] = siluf_(xq); fs[cc] = f; ks[cc] = 1.f - f;
            }
            __syncthreads();
            if (act) {
                float oo = 0.f;
#pragma unroll
                for (int i0 = 0; i0 < 128; i0 += 16) {
#pragma unroll
                    for (int i = i0; i < i0 + 16; ++i) { S[i] = fmaf(fs[i], S[i], ks[i] * iv); oo = fmaf(qs[i], S[i], oo); }
                    asm volatile("" ::: "memory"); }
                O[tok * 1024 + 512 + h * 128 + cc] = (bf16_t)(g8::cvt_pk_bf16(oo * scale, 0.f) & 0xffffu);
            }
            __syncthreads();
        }
    }
}

__device__ __forceinline__ void phase_post0(const Args& a) {
    unsigned char* ws = a.ws;
    bf16_t* O = (bf16_t*)(ws + WS_O0);
    const bf16_t* Gz = (const bf16_t*)(ws + WS_P + 3 * GRP0); const bf16_t* Hg = (const bf16_t*)(ws + WS_P + 7 * GRP0);
    const float* gnw = a.in[7]; const float* hnw = a.in[9];
    const int lane = threadIdx.x & 63, wave = threadIdx.x >> 6;
    const int hd = lane >> 3;
    const float* nw = hd < 4 ? gnw : hnw;
    for (int m = blockIdx.x * NWAVES + wave; m < NTOK; m += gridDim.x * NWAVES) {
        const u32x4* op = (const u32x4*)(O + (size_t)m * 1024 + 16 * lane);
        const bf16_t* zsrc = hd < 4 ? Gz + (size_t)m * 512 + 16 * lane : Hg + (size_t)m * 512 + 16 * lane - 512;
        const u32x4 o0 = op[0], o1 = op[1]; const u32x4 z0 = ((const u32x4*)zsrc)[0], z1 = ((const u32x4*)zsrc)[1];
        const unsigned ow[8] = {o0.x, o0.y, o0.z, o0.w, o1.x, o1.y, o1.z, o1.w}; const unsigned zw[8] = {z0.x, z0.y, z0.z, z0.w, z1.x, z1.y, z1.z, z1.w};
        float v[16], z[16]; float s = 0.f;
#pragma unroll
        for (int i = 0; i < 8; ++i) { v[2 * i] = __uint_as_float(ow[i] << 16); v[2 * i + 1] = __uint_as_float(ow[i] & 0xffff0000u); z[2 * i] = __uint_as_float(zw[i] << 16); z[2 * i + 1] = __uint_as_float(zw[i] & 0xffff0000u); }
#pragma unroll
        for (int i = 0; i < 16; ++i) s += v[i] * v[i];
        s += __shfl_xor(s, 1); s += __shfl_xor(s, 2); s += __shfl_xor(s, 4);
        const float rs = rsqrtf(s * (1.f / 128.f) + 1e-6f);
        unsigned r[8];
#pragma unroll
        for (int i = 0; i < 8; ++i) { const int c0 = (16 * lane + 2 * i) & 127;
            r[i] = g8::cvt_pk_bf16(v[2 * i] * rs * nw[c0] * siluf_(z[2 * i]), v[2 * i + 1] * rs * nw[c0 + 1] * siluf_(z[2 * i + 1])); }
        u32x4* wp = (u32x4*)(O + (size_t)m * 1024 + 16 * lane);
        wp[0] = (u32x4){r[0], r[1], r[2], r[3]}; wp[1] = (u32x4){r[4], r[5], r[6], r[7]};
    }
}

template <bool FINAL>
__device__ __forceinline__ void phase_moe_simple(const Args& a, int layer, LAS unsigned char* lds) {
    unsigned char* ws = a.ws;
    float* xio = a.out;
    const float* nw = a.in[2] + layer * 1024; const float* wc = a.in[14] + layer * 1024 * 4; const float* bc = a.in[15] + layer * 4;
    const float* wf = a.in[16] + layer * 1024 * 16; const float* bfp = a.in[17] + layer * 16;
    const float* wgu = a.in[18] + (size_t)layer * 16 * 1024 * 512; const float* wd = a.in[19] + (size_t)layer * 16 * 256 * 1024;
    const float* fw = a.in[20];
    bf16_t* XB = (bf16_t*)(ws + WS_XB); float* RS = (float*)(ws + WS_RS);
    LAS float* hs = (LAS float*)lds; LAS float* gu = hs + 1024; LAS float* actv = gu + 512; LAS float* red = actv + 256; LAS float* logits = red + 16; LAS float* selw = logits + 32; LAS int* sele = (LAS int*)(selw + 4);
    const int t = threadIdx.x;
    for (int tok = blockIdx.x; tok < NTOK; tok += gridDim.x) {
        float xv0 = xio[(size_t)tok * 1024 + t], xv1 = xio[(size_t)tok * 1024 + 512 + t];
        float s = wave_sum(xv0 * xv0 + xv1 * xv1);
        __syncthreads();
        if ((t & 63) == 0) red[t >> 6] = s;
        __syncthreads();
        s = 0.f;
#pragma unroll
        for (int i = 0; i < 8; ++i) s += red[i];
        const float rs = rsqrtf(s * (1.0f / D_MODEL) + 1e-6f);
        hs[t] = xv0 * rs * nw[t]; hs[512 + t] = xv1 * rs * nw[512 + t];
        __syncthreads();
        if (t < 20) {
            float acc = 0.f;
            if (t < 4) { for (int k = 0; k < 1024; ++k) acc = fmaf(hs[k], wc[k * 4 + t], acc); acc += bc[t]; }
            else { const int e = t - 4; for (int k = 0; k < 1024; ++k) acc = fmaf(hs[k], wf[k * 16 + e], acc); acc += bfp[e]; }
            logits[t] = acc;
        }
        __syncthreads();
        if (t == 0) {
            float mx = logits[0]; int gi = 0;
            for (int i = 1; i < 4; ++i) if (logits[i] > mx) { mx = logits[i]; gi = i; }
            float den = 0.f;
            for (int i = 0; i < 4; ++i) den += __expf(logits[i] - mx);
            const float gprob = 1.f / den;
            float f0 = logits[4 + gi * 4], f1 = logits[5 + gi * 4], f2 = logits[6 + gi * 4], f3 = logits[7 + gi * 4];
            const float fl[4] = {f0, f1, f2, f3};
            int e0 = 0; float m0 = fl[0];
            for (int i = 1; i < 4; ++i) if (fl[i] > m0) { m0 = fl[i]; e0 = i; }
            int e1 = -1; float m1 = -3.0e38f;
            for (int i = 0; i < 4; ++i) if (i != e0 && fl[i] > m1) { m1 = fl[i]; e1 = i; }
            const float p1 = __expf(m1 - m0);
            sele[0] = gi * 4 + e0; sele[1] = gi * 4 + e1;
            selw[0] = gprob / (1.f + p1); selw[1] = gprob * p1 / (1.f + p1);
        }
        __syncthreads();
        float o0 = 0.f, o1 = 0.f;
        for (int s2 = 0; s2 < 2; ++s2) {
            const int e = sele[s2]; const float gw = selw[s2];
            const float* W = wgu + (size_t)e * 1024 * 512;
            float g = 0.f;
            for (int k = 0; k < 1024; ++k) g = fmaf(hs[k], W[(size_t)k * 512 + t], g);
            gu[t] = g;
            __syncthreads();
            if (t < 256) actv[t] = siluf_(gu[t]) * gu[256 + t] * gw;
            __syncthreads();
            const float* Wd = wd + (size_t)e * 256 * 1024;
            for (int f = 0; f < 256; ++f) { const float av = actv[f]; o0 = fmaf(av, Wd[(size_t)f * 1024 + t], o0); o1 = fmaf(av, Wd[(size_t)f * 1024 + 512 + t], o1); }
        }
        xv0 += o0; xv1 += o1;
        float s3 = wave_sum(xv0 * xv0 + xv1 * xv1);
        __syncthreads();
        if ((t & 63) == 0) red[t >> 6] = s3;
        __syncthreads();
        s3 = 0.f;
#pragma unroll
        for (int i = 0; i < 8; ++i) s3 += red[i];
        const float rs2 = rsqrtf(s3 * (1.0f / D_MODEL) + 1e-6f);
        if (FINAL) { xio[(size_t)tok * 1024 + t] = xv0 * rs2 * fw[t]; xio[(size_t)tok * 1024 + 512 + t] = xv1 * rs2 * fw[512 + t]; }
        else {
            xio[(size_t)tok * 1024 + t] = xv0; xio[(size_t)tok * 1024 + 512 + t] = xv1;
            XB[(size_t)tok * 1024 + t] = (bf16_t)(g8::cvt_pk_bf16(xv0, 0.f) & 0xffffu); XB[(size_t)tok * 1024 + 512 + t] = (bf16_t)(g8::cvt_pk_bf16(xv1, 0.f) & 0xffffu);
            if (t == 0) RS[tok] = rs2;
        }
    }
}


__device__ __forceinline__ void moe_weight_items(const Args& a, int layer, LAS unsigned char* lds) {
    unsigned char* ws = a.ws;
    LAS float* tile = (LAS float*)lds;
    const float* wgu = a.in[18] + (size_t)layer * 16 * 1024 * 512; const float* wd = a.in[19] + (size_t)layer * 16 * 256 * 1024;
    const float* nw = a.in[2] + layer * 1024;
    constexpr int IG = 16 * 16 * 8, ID = 24 * 2 * 4 * 16;
    for (int it = blockIdx.x; it < IG + ID; it += gridDim.x) {
        if (it < IG) { const int e = it >> 7, r = it & 127, k0 = (r >> 3) * 64, n0 = (r & 7) * 64;
            const int u = n0 >> 8, hf = (n0 >> 7) & 1, j0 = n0 & 127;
            conv_tile(wgu + (size_t)e * 1024 * 512, 512, hf * 256 + u * 128 + j0, nw, (bf16_t*)(ws + WS_WGU) + (size_t)e * 512 * 1024, 1024, k0, n0, tile);
        } else { const int r = it - IG; const int bkt = r >> 7, q = r & 127, slot = q >> 6, kt = (q >> 4) & 3, n0 = (q & 15) * 64;
            const int g = bkt / 6, pr = bkt % 6; const int ei = pr < 3 ? 0 : (pr < 5 ? 1 : 2), ej = pr < 3 ? pr + 1 : (pr < 5 ? pr - 1 : 3);
            const int e = g * 4 + (slot ? ej : ei);
            conv_tile(wd + (size_t)e * 256 * 1024, 1024, n0, nullptr, (bf16_t*)(ws + WS_WDN) + (size_t)bkt * 1024 * 512, 512, slot * 256 + kt * 64, n0, tile, kt * 64);
        }
    }
}

__device__ __forceinline__ void phase_route(const Args& a, int layer, LAS unsigned char* lds) {
    unsigned char* ws = a.ws;
    const float* x = a.out;
    const float* nw = a.in[2] + layer * 1024; const float* wc = a.in[14] + layer * 1024 * 4; const float* bc = a.in[15] + layer * 4;
    const float* wf = a.in[16] + layer * 1024 * 16; const float* bfp = a.in[17] + layer * 16;
    int* cnt = (int*)(ws + WS_CNT) + layer * 32; int4* rec = (int4*)(ws + WS_ROWREC);
    LAS g8::f32x4* W20 = (LAS g8::f32x4*)lds;
    const int tid = threadIdx.x, lane = tid & 63, wave = tid >> 6;
    for (int i = tid; i < 5 * 1024; i += NTHREADS) { const int p = i >> 10, k = i & 1023; const float w = nw[k];
        g8::f32x4 v; if (p == 0) { v = (g8::f32x4){wc[k * 4] * w, wc[k * 4 + 1] * w, wc[k * 4 + 2] * w, wc[k * 4 + 3] * w}; }
        else { const float* q = wf + k * 16 + (p - 1) * 4; v = (g8::f32x4){q[0] * w, q[1] * w, q[2] * w, q[3] * w}; }
        W20[i] = v; }
    __syncthreads();
    for (int m = blockIdx.x * NWAVES + wave; m < NTOK; m += gridDim.x * NWAVES) {
        const float* xr = x + (size_t)m * D_MODEL + lane;
        float acc[20];
#pragma unroll
        for (int j = 0; j < 20; ++j) acc[j] = 0.f;
        float s = 0.f;
#pragma unroll 2
        for (int i = 0; i < 16; ++i) { const float xv = xr[64 * i]; s = fmaf(xv, xv, s); const int k = 64 * i + lane;
#pragma unroll
            for (int p = 0; p < 5; ++p) { const g8::f32x4 w = W20[p * 1024 + k]; acc[4 * p] = fmaf(xv, w[0], acc[4 * p]); acc[4 * p + 1] = fmaf(xv, w[1], acc[4 * p + 1]); acc[4 * p + 2] = fmaf(xv, w[2], acc[4 * p + 2]); acc[4 * p + 3] = fmaf(xv, w[3], acc[4 * p + 3]); } }
        s = wave_sum(s);
        const float rs = rsqrtf(s * (1.0f / D_MODEL) + 1e-6f);
#pragma unroll
        for (int j = 0; j < 20; ++j) acc[j] = wave_sum(acc[j]) * rs;
        if (lane == 0) {
            float c0 = acc[0] + bc[0], c1 = acc[1] + bc[1], c2 = acc[2] + bc[2], c3 = acc[3] + bc[3];
            int gi = 0; float mx = c0; if (c1 > mx) { mx = c1; gi = 1; } if (c2 > mx) { mx = c2; gi = 2; } if (c3 > mx) { mx = c3; gi = 3; }
            const float gprob = 1.f / (__expf(c0 - mx) + __expf(c1 - mx) + __expf(c2 - mx) + __expf(c3 - mx));
            float f0, f1, f2, f3;
            if (gi == 0) { f0 = acc[4]; f1 = acc[5]; f2 = acc[6]; f3 = acc[7]; } else if (gi == 1) { f0 = acc[8]; f1 = acc[9]; f2 = acc[10]; f3 = acc[11]; }
            else if (gi == 2) { f0 = acc[12]; f1 = acc[13]; f2 = acc[14]; f3 = acc[15]; } else { f0 = acc[16]; f1 = acc[17]; f2 = acc[18]; f3 = acc[19]; }
            f0 += bfp[gi * 4]; f1 += bfp[gi * 4 + 1]; f2 += bfp[gi * 4 + 2]; f3 += bfp[gi * 4 + 3];
            int e0 = 0; float m0 = f0; if (f1 > m0) { m0 = f1; e0 = 1; } if (f2 > m0) { m0 = f2; e0 = 2; } if (f3 > m0) { m0 = f3; e0 = 3; }
            int e1 = -1; float m1 = -3.0e38f;
            if (e0 != 0 && f0 > m1) { m1 = f0; e1 = 0; } if (e0 != 1 && f1 > m1) { m1 = f1; e1 = 1; } if (e0 != 2 && f2 > m1) { m1 = f2; e1 = 2; } if (e0 != 3 && f3 > m1) { m1 = f3; e1 = 3; }
            const float p1 = __expf(m1 - m0);
            const float w0 = gprob / (1.f + p1), w1 = gprob * p1 / (1.f + p1);
            const int lo = e0 < e1 ? e0 : e1, hi = e0 < e1 ? e1 : e0;
            const float wlo = e0 < e1 ? w0 : w1, whi = e0 < e1 ? w1 : w0;
            const int pr = lo == 0 ? hi - 1 : (lo == 1 ? hi + 1 : 5);
            const int bkt = gi * 6 + pr;
            const int pos = atomicAdd(cnt + bkt, 1);
            rec[(size_t)bkt * NTOK + pos] = make_int4(m, __float_as_int(rs), __float_as_int(wlo), __float_as_int(whi));
        }
    }
}

__device__ __forceinline__ void moe_table(const Args& a, int layer, LAS unsigned char* lds) {
    LAS int* tab = (LAS int*)(lds + LDS_TAB);
    const int* cnt = (const int*)(a.ws + WS_CNT) + layer * 32;
    if (threadIdx.x == 0) { int p = 0; for (int b = 0; b < 24; ++b) { const int c = __hip_atomic_load(cnt + b, __ATOMIC_RELAXED, __HIP_MEMORY_SCOPE_AGENT); tab[b] = p; tab[32 + b] = c; p += (c + 255) >> 8; } tab[24] = p; }
    __syncthreads();
}

namespace g8 {
struct MoeOrder {
    const char* A; const char* B; const int4* rec; G8_LAS const int* tab; int mode, G, c;
    __device__ __forceinline__ bool next(int i, Unit& u) const {
        const int L = i * G + c; if (L >= __builtin_amdgcn_readfirstlane(tab[24]) * 4) return false;
        const int p = L >> 2, pn = L & 3;
        int b = 0;
        for (int j = 1; j < 24; ++j) { const int tj = __builtin_amdgcn_readfirstlane(tab[j]); if (tj <= p) b = j; }
        const int pib = p - __builtin_amdgcn_readfirstlane(tab[b]); int nv = __builtin_amdgcn_readfirstlane(tab[32 + b]) - pib * 256; nv = nv > 256 ? 256 : nv;
        u.pm = p; u.pn = pn; u.aux0 = b * NTOK + pib * 256; u.aux1 = nv;
        if (mode == 0) { const int g = b / 6, pr = b % 6; const int ei = pr < 3 ? 0 : (pr < 5 ? 1 : 2), ej = pr < 3 ? pr + 1 : (pr < 5 ? pr - 1 : 3);
            const int e = g * 4 + ((pn >> 1) ? ej : ei);
            u.a = A; u.b = B + ((size_t)e * 512 + (pn & 1) * 256) * 2048; }
        else { u.a = A + (size_t)p * 256 * 1024; u.b = B + ((size_t)b * 1024 + pn * 256) * 1024; }
        return true;
    }
    __device__ __forceinline__ unsigned rowoff(const Unit& u, int r) const { const int tok = r < u.aux1 ? rec[u.aux0 + r].x : 0; return (unsigned)tok * 2048u; }
};
struct EpiGU {
    bf16_t* act; const int4* rec;
    __device__ __forceinline__ void operator()(const f32x4 (&acc)[2][2][4][2], const Unit& u, int wr, int wc, int fr, int fq) const {
        const int slot = u.pn >> 1; const int colb = slot * 256 + (u.pn & 1) * 128 + wc * 32 + 8 * fq;
#pragma unroll
        for (int ai = 0; ai < 2; ++ai)
#pragma unroll
            for (int m = 0; m < 4; ++m) { const int r = ai * HALF + wr * 64 + m * 16 + fr;
                if (r < u.aux1) { const int4 rc = rec[u.aux0 + r]; const float rs = __int_as_float(rc.y), w = __int_as_float(slot ? rc.w : rc.z);
                    float v[8];
#pragma unroll
                    for (int n = 0; n < 2; ++n)
#pragma unroll
                        for (int e = 0; e < 4; ++e) { const float g = acc[ai][0][m][n][e] * rs, up = acc[ai][1][m][n][e] * rs; v[4 * n + e] = g / (1.0f + __expf(-g)) * up * w; }
                    u32x4 o; o.x = cvt_pk_bf16(v[0], v[1]); o.y = cvt_pk_bf16(v[2], v[3]); o.z = cvt_pk_bf16(v[4], v[5]); o.w = cvt_pk_bf16(v[6], v[7]);
                    *(u32x4*)(act + ((size_t)u.pm * 256 + r) * 512 + colb) = o; }
                asm volatile("" ::: "memory"); }
    }
};
struct EpiDown {
    float* xio; bf16_t* xb; float* rowss; const int4* rec;
    __device__ __forceinline__ void operator()(const f32x4 (&acc)[2][2][4][2], const Unit& u, int wr, int wc, int fr, int fq) const {
        const int col0 = u.pn * BM + wc * 32 + 8 * fq;
#pragma unroll
        for (int ai = 0; ai < 2; ++ai)
#pragma unroll
            for (int m = 0; m < 4; ++m) { const int r = ai * HALF + wr * 64 + m * 16 + fr; const bool valid = r < u.aux1;
                float ss = 0.f; int tok = 0;
                if (valid) { tok = rec[u.aux0 + r].x; const size_t ro = (size_t)tok * 1024 + col0;
#pragma unroll
                    for (int bj = 0; bj < 2; ++bj) {
                        const f32x4 r0 = *(const f32x4*)(xio + ro + bj * HALF), r1 = *(const f32x4*)(xio + ro + bj * HALF + 4);
                        const f32x4 v0 = acc[ai][bj][m][0] + r0, v1 = acc[ai][bj][m][1] + r1;
                        *(f32x4*)(xio + ro + bj * HALF) = v0; *(f32x4*)(xio + ro + bj * HALF + 4) = v1;
                        ss += v0[0] * v0[0] + v0[1] * v0[1] + v0[2] * v0[2] + v0[3] * v0[3] + v1[0] * v1[0] + v1[1] * v1[1] + v1[2] * v1[2] + v1[3] * v1[3];
                        u32x4 w; w.x = cvt_pk_bf16(v0[0], v0[1]); w.y = cvt_pk_bf16(v0[2], v0[3]); w.z = cvt_pk_bf16(v1[0], v1[1]); w.w = cvt_pk_bf16(v1[2], v1[3]);
                        *(u32x4*)(xb + ro + bj * HALF) = w; } }
                ss += __shfl_xor(ss, 16); ss += __shfl_xor(ss, 32);
                if (valid && fq == 0) atomicAdd(rowss + tok, ss);
                asm volatile("" ::: "memory"); }
    }
};
}

__device__ __forceinline__ void phase_final(const Args& a) {
    float* x = a.out; const float* fw = a.in[20]; const float* rowss = (const float*)(a.ws + WS_ROWSS) + NTOK;
    const int lane = threadIdx.x & 63, wave = threadIdx.x >> 6;
    for (int m = blockIdx.x * NWAVES + wave; m < NTOK; m += gridDim.x * NWAVES) {
        const float rs = rsqrtf(rowss[m] * (1.0f / D_MODEL) + 1e-6f);
        float4* xr = (float4*)(x + (size_t)m * D_MODEL) + lane;
#pragma unroll
        for (int j = 0; j < 4; ++j) { float4 v = xr[64 * j]; const float4 w = ((const float4*)fw)[lane + 64 * j]; v.x *= rs * w.x; v.y *= rs * w.y; v.z *= rs * w.z; v.w *= rs * w.w; xr[64 * j] = v; }
    }
}

typedef g8::bf16x8 bf16x8;
typedef g8::f32x4 f32x4;
__device__ __forceinline__ f32x4 mfma16(bf16x8 a, bf16x8 b, f32x4 c) { return __builtin_amdgcn_mfma_f32_16x16x32_bf16(a, b, c, 0, 0, 0); }

__device__ __forceinline__ void phase_ret_prep(const Args& a, LAS unsigned char* lds) {
    unsigned char* ws = a.ws;
    bf16_t* PQ = (bf16_t*)(ws + WS_PQ); bf16_t* PK = (bf16_t*)(ws + WS_PK); bf16_t* ATT = (bf16_t*)(ws + WS_WIN0);
    LAS unsigned char* QXs = lds; LAS unsigned char* KDs = lds + 33792; LAS unsigned char* KDTs = lds + 67584; LAS unsigned char* ATs = lds + 104448;
    LAS float* invs = (LAS float*)(lds + 113664);
    const int tid = threadIdx.x, lane = tid & 63, w = tid >> 6, fr = lane & 15, fq = lane >> 4;
    if (tid < 128) invs[tid] = 1.0f / powf(10000.0f, (float)tid / 127.0f);
    __syncthreads();
    for (int it = blockIdx.x; it < 1024; it += gridDim.x) {
        const int h = (it >> 6) & 3, n = it & 63;
        const float lg = log2f(1.0f - exp2f(-5.0f - (float)h));
        {
            const int tok = tid >> 3, p0 = (tid & 7) * 16;
            const float pos = (float)(n * 64 + tok);
            const float sq = exp2f((float)(tok + 1) * lg), sk = exp2f((float)(63 - tok) * lg) * 0.0625f;
            const u32x4* qsrc = (const u32x4*)(PQ + (size_t)it * 16384 + tok * 256 + 2 * p0); const u32x4* ksrc = (const u32x4*)(PK + (size_t)it * 16384 + tok * 256 + 2 * p0);
#pragma unroll
            for (int q4 = 0; q4 < 4; ++q4) { const u32x4 qv = qsrc[q4], kv = ksrc[q4]; const unsigned qw[4] = {qv.x, qv.y, qv.z, qv.w}, kw[4] = {kv.x, kv.y, kv.z, kv.w};
                unsigned qo[4], ko[4];
#pragma unroll
                for (int e = 0; e < 4; ++e) { const int p = p0 + q4 * 4 + e; float sn, cs; sincosf(pos * invs[p], &sn, &cs);
                    const float q1 = __uint_as_float(qw[e] << 16), q2 = __uint_as_float(qw[e] & 0xffff0000u), k1 = __uint_as_float(kw[e] << 16), k2 = __uint_as_float(kw[e] & 0xffff0000u);
                    qo[e] = g8::cvt_pk_bf16((q1 * cs - q2 * sn) * sq, (q1 * sn + q2 * cs) * sq); ko[e] = g8::cvt_pk_bf16((k1 * cs - k2 * sn) * sk, (k1 * sn + k2 * cs) * sk);
                    *(LAS unsigned short*)(KDTs + (2 * p) * 144 + tok * 2) = (unsigned short)(ko[e] & 0xffffu); *(LAS unsigned short*)(KDTs + (2 * p + 1) * 144 + tok * 2) = (unsigned short)(ko[e] >> 16); }
                *(LAS u32x4*)(QXs + tok * 528 + (2 * p0 + 8 * q4) * 2) = (u32x4){qo[0], qo[1], qo[2], qo[3]}; *(LAS u32x4*)(KDs + tok * 528 + (2 * p0 + 8 * q4) * 2) = (u32x4){ko[0], ko[1], ko[2], ko[3]}; }
        }
        __syncthreads();
        {
            const int rt = w >> 1; const float ig = exp2f(-64.0f * lg);
#pragma unroll
            for (int c2 = 0; c2 < 2; ++c2) { const int ct = 2 * (w & 1) + c2; f32x4 acc = (f32x4){0.f, 0.f, 0.f, 0.f};
                if (ct <= rt) {
#pragma unroll
                    for (int ks = 0; ks < 8; ++ks) { const bf16x8 af = *(const LAS bf16x8*)(QXs + (16 * rt + fr) * 528 + (32 * ks + 8 * fq) * 2); const bf16x8 bf = *(const LAS bf16x8*)(KDs + (16 * ct + fr) * 528 + (32 * ks + 8 * fq) * 2);
                        acc = mfma16(bf, af, acc); } }
                const int i = 16 * rt + fr; float v[4];
#pragma unroll
                for (int e = 0; e < 4; ++e) { const int j = 16 * ct + 4 * fq + e; v[e] = (j <= i) ? acc[e] * ig : 0.f; }
                *(LAS u32x2*)(ATs + i * 144 + (16 * ct + 4 * fq) * 2) = (u32x2){g8::cvt_pk_bf16(v[0], v[1]), g8::cvt_pk_bf16(v[2], v[3])}; }
        }
        __syncthreads();
        {
            u32x4* qdst = (u32x4*)(PQ + (size_t)it * 16384); u32x4* kdst = (u32x4*)(PK + (size_t)it * 16384); u32x4* adst = (u32x4*)(ATT + (size_t)it * 4096);
#pragma unroll
            for (int i = 0; i < 4; ++i) { const int q = tid + 512 * i, tile = q >> 6, l = q & 63;
                { const int rt = tile >> 3, ks = tile & 7; qdst[q] = *(const LAS u32x4*)(QXs + (16 * rt + (l & 15)) * 528 + (32 * ks + 8 * (l >> 4)) * 2); }
                { const int rt = tile >> 1, ks = tile & 1; kdst[q] = *(const LAS u32x4*)(KDTs + (16 * rt + (l & 15)) * 144 + (32 * ks + 8 * (l >> 4)) * 2); } }
            { const int tile = tid >> 6, l = tid & 63; const int rt = tile >> 1, ks = tile & 1; adst[tid] = *(const LAS u32x4*)(ATs + (16 * rt + (l & 15)) * 144 + (32 * ks + 8 * (l >> 4)) * 2); }
        }
        __syncthreads();
    }
}

__device__ __forceinline__ void phase_ret_scan(const Args& a, LAS unsigned char* lds) {
    unsigned char* ws = a.ws;
    const bf16_t* QX = (const bf16_t*)(ws + WS_PQ); const bf16_t* KDT = (const bf16_t*)(ws + WS_PK); const bf16_t* ATT = (const bf16_t*)(ws + WS_WIN0); bf16_t* PV = (bf16_t*)(ws + WS_PV);
    const int tid = threadIdx.x, lane = tid & 63, w = __builtin_amdgcn_readfirstlane(tid >> 6), fr = lane & 15, fq = lane >> 4;
    for (int it = blockIdx.x; it < 256; it += gridDim.x) {
        const int bh = (it & 7) | ((it >> 7) << 3), sl = (it >> 3) & 15, b = bh >> 2, h = bh & 3;
        const float cdec = exp2f(64.0f * log2f(1.0f - exp2f(-5.0f - (float)h)));
        const int rt = w >> 1, cto = w & 1;
        f32x4 sacc[2][2];
#pragma unroll
        for (int r = 0; r < 2; ++r)
#pragma unroll
            for (int c = 0; c < 2; ++c) sacc[r][c] = (f32x4){0.f, 0.f, 0.f, 0.f};
        const int vtok = tid >> 3, vdv = (tid & 7) * 4;
        bf16_t* vbase = PV + ((size_t)b * SEQ) * 2048 + h * 512 + sl * 32;
        for (int n = 0; n < 64; ++n) {
            const size_t blk = (size_t)bh * 64 + n;
            const bf16x8* qb = (const bf16x8*)(QX + blk * 16384) + lane; const bf16x8* kb = (const bf16x8*)(KDT + blk * 16384) + lane; const bf16x8* ab = (const bf16x8*)(ATT + blk * 4096) + lane;
            bf16x8 qf[8], af[2], kf[2][2];
#pragma unroll
            for (int ks = 0; ks < 8; ++ks) qf[ks] = qb[(rt * 8 + ks) * 64];
#pragma unroll
            for (int k2 = 0; k2 < 2; ++k2) af[k2] = ab[(rt * 2 + k2) * 64];
#pragma unroll
            for (int r = 0; r < 2; ++r)
#pragma unroll
                for (int k2 = 0; k2 < 2; ++k2) kf[r][k2] = kb[((2 * w + r) * 2 + k2) * 64];
            const u32x2 vv = *(const u32x2*)(vbase + (size_t)(n * 64 + vtok) * 2048 + vdv);
            LAS unsigned char* STs = lds + (n & 1) * 16896;
            LAS unsigned char* VTs = lds + 33792 + (n & 1) * 4608;
#pragma unroll
            for (int r = 0; r < 2; ++r)
#pragma unroll
                for (int c = 0; c < 2; ++c) { const f32x4 v = sacc[r][c];
                    *(LAS u32x2*)(STs + (16 * c + fr) * 528 + (16 * (2 * w + r) + 4 * fq) * 2) = (u32x2){g8::cvt_pk_bf16(v[0], v[1]), g8::cvt_pk_bf16(v[2], v[3])}; }
            *(LAS unsigned short*)(VTs + (vdv + 0) * 144 + vtok * 2) = (unsigned short)(vv.x & 0xffffu); *(LAS unsigned short*)(VTs + (vdv + 1) * 144 + vtok * 2) = (unsigned short)(vv.x >> 16);
            *(LAS unsigned short*)(VTs + (vdv + 2) * 144 + vtok * 2) = (unsigned short)(vv.y & 0xffffu); *(LAS unsigned short*)(VTs + (vdv + 3) * 144 + vtok * 2) = (unsigned short)(vv.y >> 16);
            __syncthreads();
            f32x4 o = (f32x4){0.f, 0.f, 0.f, 0.f};
#pragma unroll
            for (int ks = 0; ks < 8; ++ks) { const bf16x8 sb = *(const LAS bf16x8*)(STs + (16 * cto + fr) * 528 + (32 * ks + 8 * fq) * 2); o = mfma16(sb, qf[ks], o); }
            bf16x8 vb[2][2];
#pragma unroll
            for (int c = 0; c < 2; ++c)
#pragma unroll
                for (int k2 = 0; k2 < 2; ++k2) vb[c][k2] = *(const LAS bf16x8*)(VTs + (16 * c + fr) * 144 + (32 * k2 + 8 * fq) * 2);
#pragma unroll
            for (int k2 = 0; k2 < 2; ++k2) o = mfma16(vb[cto][k2], af[k2], o);
#pragma unroll
            for (int r = 0; r < 2; ++r)
#pragma unroll
                for (int c = 0; c < 2; ++c) { f32x4 t = sacc[r][c] * cdec;
#pragma unroll
                    for (int k2 = 0; k2 < 2; ++k2) t = mfma16(kf[r][k2], vb[c][k2], t);
                    sacc[r][c] = t; }
            *(u32x2*)(vbase + (size_t)(n * 64 + 16 * rt + fr) * 2048 + 16 * cto + 4 * fq) = (u32x2){g8::cvt_pk_bf16(o[0], o[1]), g8::cvt_pk_bf16(o[2], o[3])};
        }
        __syncthreads();
    }
}

__device__ __forceinline__ void phase_post1(const Args& a) {
    unsigned char* ws = a.ws;
    bf16_t* O = (bf16_t*)(ws + WS_PV); const bf16_t* G = (const bf16_t*)(ws + WS_PG);
    const float* nw = a.in[12];
    const int lane = threadIdx.x & 63, wave = threadIdx.x >> 6;
    for (int m = blockIdx.x * NWAVES + wave; m < NTOK; m += gridDim.x * NWAVES) {
        float v[32], z[32]; float s = 0.f;
#pragma unroll
        for (int q = 0; q < 4; ++q) {
            const u32x4 o = *((const u32x4*)(O + (size_t)m * 2048 + 32 * lane) + q); const u32x4 zz = *((const u32x4*)(G + (size_t)m * 2048 + 32 * lane) + q);
            const unsigned ow[4] = {o.x, o.y, o.z, o.w}; const unsigned zw[4] = {zz.x, zz.y, zz.z, zz.w};
#pragma unroll
            for (int i = 0; i < 4; ++i) { v[8 * q + 2 * i] = __uint_as_float(ow[i] << 16); v[8 * q + 2 * i + 1] = __uint_as_float(ow[i] & 0xffff0000u);
                z[8 * q + 2 * i] = __uint_as_float(zw[i] << 16); z[8 * q + 2 * i + 1] = __uint_as_float(zw[i] & 0xffff0000u); }
        }
#pragma unroll
        for (int i = 0; i < 32; ++i) s += v[i] * v[i];
        s += __shfl_xor(s, 1); s += __shfl_xor(s, 2); s += __shfl_xor(s, 4); s += __shfl_xor(s, 8);
        const float rs = rsqrtf(s * (1.f / 512.f) + 1e-6f);
#pragma unroll
        for (int q = 0; q < 4; ++q) {
            unsigned r[4];
#pragma unroll
            for (int i = 0; i < 4; ++i) { const int j = 8 * q + 2 * i; const int c0 = (32 * lane + j) & 511;
                r[i] = g8::cvt_pk_bf16(v[j] * rs * nw[c0] * siluf_(z[j]), v[j + 1] * rs * nw[c0 + 1] * siluf_(z[j + 1])); }
            *((u32x4*)(O + (size_t)m * 2048 + 32 * lane) + q) = (u32x4){r[0], r[1], r[2], r[3]};
        }
    }
}


#define GRID_SYNC() do { asm volatile("s_waitcnt vmcnt(0)" ::: "memory"); grid.sync(); \
    if (threadIdx.x == 0) { __builtin_amdgcn_fence(__ATOMIC_ACQUIRE, "agent"); asm volatile("s_waitcnt vmcnt(0)" ::: "memory"); } \
    __syncthreads(); } while (0)

__global__ void __launch_bounds__(NTHREADS, 2) mega(Args a) {
    extern __shared__ __attribute__((aligned(16))) unsigned char lds_raw[];
    LAS unsigned char* lds = (LAS unsigned char*)lds_raw;
    cg::grid_group grid = cg::this_grid();
    unsigned char* ws = a.ws;
    const int G = gridDim.x, c = blockIdx.x;

    phase_prep(a, lds);
    GRID_SYNC();
    {
        g8::DenseOrder S{(const char*)(ws + WS_XB), (const char*)(ws + WS_WIN0), 2048, 2048, NTOK / 256, 16, G, c};
        g8::EpiGroups E{(bf16_t*)(ws + WS_P), (const float*)(ws + WS_RS), 2, 512, GRP0 / 2};
        g8::gemm_phase<g8::EpiGroups, g8::DenseOrder>(lds, 2048, 2048, 1024, S, E);
    }
    GRID_SYNC();
    phase_mix0_simple(a, lds);
    GRID_SYNC();
    phase_post0(a);
    moe_weight_items(a, 0, lds);
    GRID_SYNC();
    {
        g8::DenseOrder S{(const char*)(ws + WS_O0), (const char*)(ws + WS_WOUT0), 2048, 2048, NTOK / 256, 4, G, c};
        g8::EpiRes E{a.in[0], a.out, (bf16_t*)(ws + WS_XB)};
        g8::gemm_phase<g8::EpiRes, g8::DenseOrder>(lds, 2048, 2048, 1024, S, E);
    }
    GRID_SYNC();
#define MOE_LAYER(layer) do { \
    phase_route(a, layer, lds); \
    GRID_SYNC(); \
    moe_table(a, layer, lds); \
    {   g8::MoeOrder S{(const char*)(ws + WS_XB), (const char*)(ws + WS_WGU), (const int4*)(ws + WS_ROWREC), (LAS const int*)(lds + LDS_TAB), 0, G, c}; \
        g8::EpiGU E{(bf16_t*)(ws + WS_ACT), (const int4*)(ws + WS_ROWREC)}; \
        g8::gemm_phase<g8::EpiGU, g8::MoeOrder, true>(lds, 2048, 2048, 1024, S, E); } \
    GRID_SYNC(); \
    {   g8::MoeOrder S{(const char*)(ws + WS_ACT), (const char*)(ws + WS_WDN), (const int4*)(ws + WS_ROWREC), (LAS const int*)(lds + LDS_TAB), 1, G, c}; \
        g8::EpiDown E{a.out, (bf16_t*)(ws + WS_XB), (float*)(ws + WS_ROWSS) + (layer) * NTOK, (const int4*)(ws + WS_ROWREC)}; \
        g8::gemm_phase<g8::EpiDown, g8::MoeOrder, false>(lds, 1024, 1024, 512, S, E); } \
    GRID_SYNC(); } while (0)
    MOE_LAYER(0);
    {
        g8::DenseOrder S{(const char*)(ws + WS_XB), (const char*)(ws + WS_WIN1), 2048, 2048, NTOK / 256, 24, G, c};
        g8::EpiOdd E{(bf16_t*)(ws + WS_PQ), (bf16_t*)(ws + WS_PK), (bf16_t*)(ws + WS_PV), (bf16_t*)(ws + WS_PG), (const float*)(ws + WS_ROWSS)};
        g8::gemm_phase<g8::EpiOdd, g8::DenseOrder>(lds, 2048, 2048, 1024, S, E);
    }
    GRID_SYNC();
    phase_ret_prep(a, lds);
    GRID_SYNC();
    phase_ret_scan(a, lds);
    GRID_SYNC();
    phase_post1(a);
    moe_weight_items(a, 1, lds);
    GRID_SYNC();
    {
        g8::DenseOrder S{(const char*)(ws + WS_PV), (const char*)(ws + WS_WOUT1), 4096, 4096, NTOK / 256, 4, G, c};
        g8::EpiRes E{a.out, a.out, (bf16_t*)(ws + WS_XB)};
        g8::gemm_phase<g8::EpiRes, g8::DenseOrder>(lds, 4096, 4096, 2048, S, E);
    }
    GRID_SYNC();
    MOE_LAYER(1);
    phase_final(a);
}

extern "C" void kernel_launch(void* const* d_in, const int* in_sizes, int n_in, void* d_out, int out_size, void* d_ws, size_t ws_size, hipStream_t stream) {
    static int grid_blocks = 0;
    if (!grid_blocks) {
        if (ws_size < WS_END || n_in != 21) { fprintf(stderr, "kernel_launch: ws %zu < %zu or n_in %d\n", ws_size, (size_t)WS_END, n_in); grid_blocks = -1; return; }
        int dev = 0, cus = 0, per_cu = 0;
        (void)hipGetDevice(&dev);
        (void)hipDeviceGetAttribute(&cus, hipDeviceAttributeMultiprocessorCount, dev);
        (void)hipFuncSetAttribute((const void*)mega, hipFuncAttributeMaxDynamicSharedMemorySize, LDS_BYTES);
        (void)hipOccupancyMaxActiveBlocksPerMultiprocessor(&per_cu, (const void*)mega, NTHREADS, LDS_BYTES);
        if (per_cu < 1) { fprintf(stderr, "kernel_launch: occupancy query says %d blocks per CU\n", per_cu); grid_blocks = -1; return; }
        grid_blocks = cus;
    }
    if (grid_blocks < 0) return;
    Args a{};
    for (int i = 0; i < 21; ++i) a.in[i] = (const float*)d_in[i];
    a.out = (float*)d_out; a.ws = (unsigned char*)d_ws;
    void* args[] = {&a};
    hipError_t e = hipLaunchCooperativeKernel((const void*)mega, dim3(grid_blocks), dim3(NTHREADS), args, LDS_BYTES, stream);
    if (e != hipSuccess) fprintf(stderr, "cooperative launch failed: %s (grid %d)\n", hipGetErrorString(e), grid_blocks);
}
```

```cpp
#include <hip/hip_runtime.h>
#include <hip/hip_cooperative_groups.h>
#include <cstdint>
#include <cstdio>
namespace cg = cooperative_groups;

#define D_MODEL 1024
#define BATCH 4
#define SEQ 4096
#define NTOK (BATCH * SEQ)
#define EVEN_IN 4104
#define ODD_IN 6144
#define NTHREADS 512
#define NWAVES 8

__device__ __forceinline__ float sigmoidf_(float x) { return 1.0f / (1.0f + __expf(-x)); }
__device__ __forceinline__ float siluf_(float x) { return x / (1.0f + __expf(-x)); }
__device__ __forceinline__ float softplusf_(float x) { return x > 20.f ? x : log1pf(__expf(x)); }
__device__ __forceinline__ float bf2f(unsigned short b) { return __uint_as_float(((unsigned)b) << 16); }
__device__ __forceinline__ float wave_sum(float v) { for (int o = 32; o > 0; o >>= 1) v += __shfl_xor(v, o); return v; }

namespace g8 {
#define G8_LAS __attribute__((address_space(3)))
typedef unsigned short bf16_t;
typedef short bf16x8 __attribute__((ext_vector_type(8)));
typedef float f32x4 __attribute__((ext_vector_type(4)));
typedef unsigned u32x4 __attribute__((ext_vector_type(4)));
typedef unsigned u32x2 __attribute__((ext_vector_type(2)));
constexpr int BM = 256, BK = 64, HALF = 128, HTB = HALF * BK * 2, STAGE_BYTES = 8 * HTB;

__host__ __device__ __forceinline__ int lds_byte(int r, int c) { const int st = (r >> 4) * 2 + (c >> 5), rr = r & 15, cc = c & 31, ob = rr * 64 + cc * 2; return st * 1024 + (ob ^ (((ob >> 9) & 1) << 5)); }
__host__ __device__ __forceinline__ void stage_rc(int b, int& R, int& C) { const int st = b / 1024, sb = b % 1024, swz = sb ^ (((sb >> 9) & 1) << 5); R = (st >> 1) * 16 + swz / 64; C = (st & 1) * 32 + (swz % 64) / 2; }
__host__ __device__ __forceinline__ int perm32(int rho) { const int n = rho >> 4, i = rho & 15; return 8 * (i >> 2) + 4 * n + (i & 3); }
typedef float cvt_f2 __attribute__((ext_vector_type(2)));
typedef __bf16 cvt_b2 __attribute__((ext_vector_type(2)));
__device__ __forceinline__ unsigned cvt_pk_bf16(float lo, float hi) { const cvt_f2 v = {lo, hi}; return __builtin_bit_cast(unsigned, __builtin_convertvector(v, cvt_b2)); }

struct Unit { const char* a; const char* b; int pm, pn, aux0, aux1; };

template <class Epi, class Sched, bool GATHER = false>
__device__ __forceinline__ void gemm_phase(G8_LAS unsigned char* lds, const int lda, const int ldb, const int K, const Sched& S, const Epi& E) {
    const int tid = threadIdx.x, wid = __builtin_amdgcn_readfirstlane(tid >> 6), lane = tid & 63, wr = wid >> 2, wc = wid & 3, fr = lane & 15, fq = lane >> 4;
    const int nt = K / BK;
    unsigned voffB[2];
#pragma unroll
    for (int i = 0; i < 2; ++i) { int R, C; stage_rc(tid * 16 + i * 8192, R, C); const int Rb = (R & ~31) + perm32(R & 31);
        voffB[i] = (unsigned)(Rb * ldb + C * 2); }
    unsigned vA[2][2], vAn[2][2];
    const size_t kstep = (size_t)(BK * 2);
    const size_t hstepB = (size_t)HALF * ldb;
    const unsigned ldsw = (unsigned)wid * 1024u;
    const int aoff = lds_byte(wr * 64 + fr, fq * 8), boff = lds_byte(wc * 32 + fr, fq * 8);
#define G8_SA(b, h) (((b) * 2 + (h)) * HTB)
#define G8_SB(b, h) ((4 + (b) * 2 + (h)) * HTB)
#define G8_STAGE(bufoff, gbase, voff) do { _Pragma("unroll") for (int _i = 0; _i < 2; ++_i) \
        __builtin_amdgcn_global_load_lds((const unsigned*)((const char*)(gbase) + (voff)[_i]), (G8_LAS unsigned*)(lds + (bufoff) + ldsw + _i * 8192), 16, 0, 0); } while (0)
#define G8_SETV(V, u) do { int _t = tid; asm volatile("" : "+v"(_t)); _Pragma("unroll") for (int _i = 0; _i < 2; ++_i) { int _R, _C; stage_rc(_t * 16 + _i * 8192, _R, _C); \
        _Pragma("unroll") for (int _h = 0; _h < 2; ++_h) V[_h][_i] = (GATHER ? S.rowoff(u, _h * HALF + _R) : (unsigned)((_h * HALF + _R) * lda)) + (unsigned)(_C * 2); } } while (0)
#define G8_LDA(dst, b, h) do { _Pragma("unroll") for (int m = 0; m < 4; ++m) _Pragma("unroll") for (int k = 0; k < 2; ++k) dst[m][k] = *(const G8_LAS bf16x8*)(lds + G8_SA(b, h) + aoff + m * 2048 + k * 1024); } while (0)
#define G8_LDB(dst, b, h) do { _Pragma("unroll") for (int n = 0; n < 2; ++n) _Pragma("unroll") for (int k = 0; k < 2; ++k) dst[n][k] = *(const G8_LAS bf16x8*)(lds + G8_SB(b, h) + boff + n * 2048 + k * 1024); } while (0)
#define G8_MMA(ai, bj, At, Bt) do { __builtin_amdgcn_s_setprio(1); _Pragma("unroll") for (int m = 0; m < 4; ++m) _Pragma("unroll") for (int n = 0; n < 2; ++n) _Pragma("unroll") for (int k = 0; k < 2; ++k) \
        acc[ai][bj][m][n] = __builtin_amdgcn_mfma_f32_16x16x32_bf16(Bt[n][k], At[m][k], acc[ai][bj][m][n], 0, 0, 0); __builtin_amdgcn_s_setprio(0); } while (0)
#define G8_WAIT_V(n) asm volatile("s_waitcnt vmcnt(" #n ")" ::: "memory")
#define G8_WAIT_L(n) asm volatile("s_waitcnt lgkmcnt(" #n ")" ::: "memory")
#define G8_BAR __builtin_amdgcn_s_barrier()
#define G8_SCHED __builtin_amdgcn_sched_barrier(0)
    Unit cur, nxt; int ui = 0;
    if (!S.next(0, cur)) return;
    f32x4 acc[2][2][4][2];
#pragma unroll
    for (int a = 0; a < 2; ++a)
#pragma unroll
        for (int b = 0; b < 2; ++b)
#pragma unroll
            for (int m = 0; m < 4; ++m)
#pragma unroll
                for (int n = 0; n < 2; ++n) acc[a][b][m][n] = (f32x4){0.f, 0.f, 0.f, 0.f};
    bf16x8 At[4][2], B0[2][2], B1[2][2];
    const char* cA = cur.a; const char* cB = cur.b;
    G8_SETV(vA, cur);
    if (GATHER) asm volatile("s_waitcnt vmcnt(0)" ::: "memory");
    G8_STAGE(G8_SB(0, 0), cB, voffB); G8_STAGE(G8_SA(0, 0), cA, vA[0]); G8_STAGE(G8_SB(0, 1), cB + hstepB, voffB); G8_STAGE(G8_SA(0, 1), cA, vA[1]);
    if (wr == 1) G8_BAR;
    G8_WAIT_V(4); G8_BAR;
    G8_STAGE(G8_SB(1, 0), cB + kstep, voffB); G8_STAGE(G8_SA(1, 0), cA + kstep, vA[0]); G8_STAGE(G8_SB(1, 1), cB + hstepB + kstep, voffB);
    G8_WAIT_V(6); G8_BAR;
    for (;;) {
        const bool has_next = S.next(ui + 1, nxt);
        const char* nA = has_next ? nxt.a : cA; const char* nB = has_next ? nxt.b : cB;
        if (GATHER && has_next) { G8_SETV(vAn, nxt); }
        else {
#pragma unroll
            for (int _h = 0; _h < 2; ++_h)
#pragma unroll
                for (int _i = 0; _i < 2; ++_i) vAn[_h][_i] = vA[_h][_i]; }
        for (int t = 0; t < nt; t += 2) {
            const bool last = (t == nt - 2);
            const char* a1 = cA + (size_t)(t + 1) * kstep;
            const char* a2 = last ? nA : cA + (size_t)(t + 2) * kstep; const char* b2 = last ? nB : cB + (size_t)(t + 2) * kstep;
            const char* a3 = a2 + kstep; const char* b3 = b2 + kstep;
            unsigned o2[2][2];
#pragma unroll
            for (int _h = 0; _h < 2; ++_h)
#pragma unroll
                for (int _i = 0; _i < 2; ++_i) o2[_h][_i] = (GATHER && last) ? vAn[_h][_i] : vA[_h][_i];
            G8_LDB(B0, 0, 0); G8_SCHED; G8_LDA(At, 0, 0); G8_STAGE(G8_SA(1, 1), a1, vA[1]);
            G8_WAIT_L(8); G8_BAR; G8_WAIT_L(0); G8_MMA(0, 0, At, B0); G8_BAR; G8_SCHED;
            G8_LDB(B1, 0, 1); G8_STAGE(G8_SB(0, 0), b2, voffB);
            G8_BAR; G8_WAIT_L(0); G8_MMA(0, 1, At, B1); G8_BAR;
            G8_LDA(At, 0, 1); G8_STAGE(G8_SA(0, 0), a2, o2[0]);
            G8_BAR; G8_WAIT_L(0); G8_MMA(1, 0, At, B0); G8_BAR; G8_SCHED;
            G8_STAGE(G8_SB(0, 1), b2 + hstepB, voffB);
            G8_WAIT_V(6); G8_BAR; G8_MMA(1, 1, At, B1); G8_BAR;
            G8_LDB(B0, 1, 0); G8_SCHED; G8_LDA(At, 1, 0); G8_STAGE(G8_SA(0, 1), a2, o2[1]);
            G8_WAIT_L(8); G8_BAR; G8_WAIT_L(0); G8_MMA(0, 0, At, B0); G8_BAR; G8_SCHED;
            G8_LDB(B1, 1, 1); G8_STAGE(G8_SB(1, 0), b3, voffB);
            G8_BAR; G8_WAIT_L(0); G8_MMA(0, 1, At, B1); G8_BAR;
            G8_LDA(At, 1, 1); G8_STAGE(G8_SA(1, 0), a3, o2[0]);
            G8_BAR; G8_WAIT_L(0); G8_MMA(1, 0, At, B0); G8_BAR; G8_SCHED;
            G8_STAGE(G8_SB(1, 1), b3 + hstepB, voffB);
            G8_WAIT_V(6); G8_BAR; G8_MMA(1, 1, At, B1); G8_BAR;
        }
        { int fr_ = fr, fq_ = fq; asm volatile("" : "+v"(fr_), "+v"(fq_)); E(acc, cur, wr, wc, fr_, fq_); }
        if (!has_next) break;
#pragma unroll
        for (int a = 0; a < 2; ++a)
#pragma unroll
            for (int b = 0; b < 2; ++b)
#pragma unroll
                for (int m = 0; m < 4; ++m)
#pragma unroll
                    for (int n = 0; n < 2; ++n) acc[a][b][m][n] = (f32x4){0.f, 0.f, 0.f, 0.f};
        cur = nxt; cA = nA; cB = nB; ++ui;
#pragma unroll
        for (int _h = 0; _h < 2; ++_h)
#pragma unroll
            for (int _i = 0; _i < 2; ++_i) vA[_h][_i] = vAn[_h][_i];
    }
    G8_WAIT_V(0);
    if (wr == 0) G8_BAR;
    G8_BAR;
#undef G8_SA
#undef G8_SB
#undef G8_STAGE
#undef G8_SETV
#undef G8_LDA
#undef G8_LDB
#undef G8_MMA
#undef G8_WAIT_V
#undef G8_WAIT_L
#undef G8_BAR
#undef G8_SCHED
}


struct DenseOrder {
    const char* A; const char* B; int lda, ldb, nM, nN, G, c;
    __device__ __forceinline__ bool next(int i, Unit& u) const {
        const int L = i * G + c; if (L >= nM * nN) return false;
        const int grp = L / (8 * nN), rem = L % (8 * nN); const int gsz = (nM - grp * 8) < 8 ? (nM - grp * 8) : 8;
        u.pm = grp * 8 + rem % gsz; u.pn = rem / gsz;
        u.a = A + (size_t)u.pm * BM * lda; u.b = B + (size_t)u.pn * BM * ldb; u.aux0 = 0; u.aux1 = 0; return true;
    }
    __device__ __forceinline__ unsigned rowoff(const Unit&, int) const { return 0u; }
};

struct EpiGroups {
    bf16_t* dst; const float* rs; int upg; int ld; size_t gstride;
    __device__ __forceinline__ void operator()(const f32x4 (&acc)[2][2][4][2], const Unit& u, int wr, int wc, int fr, int fq) const {
        const int row0 = u.pm * BM + wr * 64 + fr;
        const int grp = u.pn / upg; const bool blocked = (grp == 4 || grp == 5);
        bf16_t* base = dst + (size_t)grp * gstride + (blocked ? 0 : (u.pn % upg) * 256) + wc * 32 + 8 * fq;
#pragma unroll
        for (int ai = 0; ai < 2; ++ai)
#pragma unroll
            for (int m = 0; m < 4; ++m) { const int row = row0 + ai * HALF + m * 16; const float sc = rs[row];
#pragma unroll
                for (int bj = 0; bj < 2; ++bj) { const f32x4 v0 = acc[ai][bj][m][0] * sc, v1 = acc[ai][bj][m][1] * sc;
                    u32x4 w; w.x = cvt_pk_bf16(v0[0], v0[1]); w.y = cvt_pk_bf16(v0[2], v0[3]); w.z = cvt_pk_bf16(v1[0], v1[1]); w.w = cvt_pk_bf16(v1[2], v1[3]);
                    bf16_t* p = blocked ? base + ((size_t)(((row >> 12) * 4 + 2 * (u.pn % upg) + bj) * 64 + ((row & 4095) >> 6)) * 64 + (row & 63)) * 128
                                        : base + (size_t)row * ld + bj * HALF;
                    *(u32x4*)p = w; } }
    }
};
struct EpiOdd {
    bf16_t* pq; bf16_t* pk; bf16_t* pv; bf16_t* pg; const float* rowss;
    __device__ __forceinline__ void operator()(const f32x4 (&acc)[2][2][4][2], const Unit& u, int wr, int wc, int fr, int fq) const {
        const int row0 = u.pm * BM + wr * 64 + fr;
        bf16_t* base; int ld, ct; const bool blocked = u.pn < 8;
        if (u.pn < 4) { base = pq; ld = 1024; ct = u.pn; } else if (u.pn < 8) { base = pk; ld = 1024; ct = u.pn - 4; }
        else if (u.pn < 16) { base = pv; ld = 2048; ct = u.pn - 8; } else { base = pg; ld = 2048; ct = u.pn - 16; }
        base += (blocked ? 0 : ct * 256) + wc * 32 + 8 * fq;
#pragma unroll
        for (int ai = 0; ai < 2; ++ai)
#pragma unroll
            for (int m = 0; m < 4; ++m) { const int row = row0 + ai * HALF + m * 16; float ssum = 0.f;
                { const f32x4* pp = (const f32x4*)(rowss + (size_t)row * 16);
#pragma unroll
                  for (int q4 = 0; q4 < 4; ++q4) { const f32x4 t4 = pp[q4]; ssum += (t4[0] + t4[1]) + (t4[2] + t4[3]); } }
                const float sc = rsqrtf(ssum * (1.0f / 1024.0f) + 1e-6f);
                bf16_t* rowp = blocked ? base + ((size_t)(((row >> 12) * 4 + ct) * 64 + ((row & 4095) >> 6)) * 64 + (row & 63)) * 256 : base + (size_t)row * ld;
#pragma unroll
                for (int bj = 0; bj < 2; ++bj) { const f32x4 v0 = acc[ai][bj][m][0] * sc, v1 = acc[ai][bj][m][1] * sc;
                    u32x4 w; w.x = cvt_pk_bf16(v0[0], v0[1]); w.y = cvt_pk_bf16(v0[2], v0[3]); w.z = cvt_pk_bf16(v1[0], v1[1]); w.w = cvt_pk_bf16(v1[2], v1[3]);
                    *(u32x4*)(rowp + bj * HALF) = w; } }
    }
};
struct EpiRes {
    const float* xin; float* xout; bf16_t* xb;
    __device__ __forceinline__ void operator()(const f32x4 (&acc)[2][2][4][2], const Unit& u, int wr, int wc, int fr, int fq) const {
        const int row0 = u.pm * BM + wr * 64 + fr; const int col0 = u.pn * BM + wc * 32 + 8 * fq;
#pragma unroll
        for (int ai = 0; ai < 2; ++ai)
#pragma unroll
            for (int m = 0; m < 4; ++m) { const size_t ro = (size_t)(row0 + ai * HALF + m * 16) * 1024 + col0;
#pragma unroll
                for (int bj = 0; bj < 2; ++bj) {
                    const f32x4 r0 = *(const f32x4*)(xin + ro + bj * HALF), r1 = *(const f32x4*)(xin + ro + bj * HALF + 4);
                    const f32x4 v0 = acc[ai][bj][m][0] + r0, v1 = acc[ai][bj][m][1] + r1;
                    *(f32x4*)(xout + ro + bj * HALF) = v0; *(f32x4*)(xout + ro + bj * HALF + 4) = v1;
                    u32x4 w; w.x = cvt_pk_bf16(v0[0], v0[1]); w.y = cvt_pk_bf16(v0[2], v0[3]); w.z = cvt_pk_bf16(v1[0], v1[1]); w.w = cvt_pk_bf16(v1[2], v1[3]);
                    *(u32x4*)(xb + ro + bj * HALF) = w; } }
    }
};
}
typedef g8::bf16_t bf16_t;
typedef g8::u32x4 u32x4;
typedef g8::u32x2 u32x2;
#define LAS __attribute__((address_space(3)))

constexpr size_t MiB = (size_t)1 << 20;
constexpr size_t WS_RS = 64 * 1024;
constexpr size_t WS_GATES = 128 * 1024;
constexpr size_t WS_XB = 4 * MiB;
constexpr size_t WS_WIN0 = 36 * MiB;
constexpr size_t WS_WOUT0 = 44 * MiB;
constexpr size_t WS_WIN1 = 46 * MiB;
constexpr size_t WS_WOUT1 = 58 * MiB;
constexpr size_t WS_P = 62 * MiB;
constexpr size_t GRP0 = 16 * MiB;
constexpr size_t WS_O0 = WS_P + 8 * GRP0;
constexpr size_t WS_PQ = WS_P, WS_PK = WS_P + 32 * MiB, WS_PV = WS_P + 64 * MiB, WS_PG = WS_P + 128 * MiB;
constexpr size_t WS_END = WS_P + 192 * MiB;
constexpr size_t WS_CNT = 1024;
constexpr size_t WS_ROWSS = 1 * MiB;
constexpr size_t WS_ROWREC = WS_WIN0;
constexpr size_t WS_WGU = WS_P;
constexpr size_t WS_WDN = WS_P + 16 * MiB;
constexpr size_t WS_ACT = WS_P + 40 * MiB;
constexpr size_t WS_HATT = WS_P + 160 * MiB;
constexpr size_t WS_HDEC = WS_P + 168 * MiB;
constexpr size_t WS_GQG = WS_XB;
constexpr size_t WS_GKDT = WS_XB + 16 * MiB;
constexpr size_t WS_GATT = WS_WIN0;
constexpr size_t WS_GWN = WS_WIN1;
constexpr size_t WS_GU = WS_P + 170 * MiB;
constexpr size_t WS_GEG = WS_P + 187 * MiB;
constexpr int LDS_TAB = g8::STAGE_BYTES;
constexpr int LDS_BYTES = g8::STAGE_BYTES + 1024;

struct Args { const float* in[21]; float* out; unsigned char* ws; };

__device__ __forceinline__ void conv_tile(const float* __restrict__ W, int ldw, int srccol0, const float* __restrict__ scale, bf16_t* __restrict__ Wt, int K, int k0, int n0, LAS float* tile, int ks0 = -1) {
    if (ks0 < 0) ks0 = k0;
    const int t = threadIdx.x;
    for (int i = t; i < 64 * 64; i += NTHREADS) { const int kk = i >> 6, nn = i & 63; float v = W[(size_t)(ks0 + kk) * ldw + srccol0 + nn]; if (scale) v *= scale[ks0 + kk]; tile[kk * 65 + nn] = v; }
    __syncthreads();
    { const int nn = t >> 3, kc = t & 7;
      u32x4 o; o.x = g8::cvt_pk_bf16(tile[(kc * 8 + 0) * 65 + nn], tile[(kc * 8 + 1) * 65 + nn]); o.y = g8::cvt_pk_bf16(tile[(kc * 8 + 2) * 65 + nn], tile[(kc * 8 + 3) * 65 + nn]);
      o.z = g8::cvt_pk_bf16(tile[(kc * 8 + 4) * 65 + nn], tile[(kc * 8 + 5) * 65 + nn]); o.w = g8::cvt_pk_bf16(tile[(kc * 8 + 6) * 65 + nn], tile[(kc * 8 + 7) * 65 + nn]);
      *(u32x4*)(Wt + (size_t)(n0 + nn) * K + k0 + kc * 8) = o; }
    __syncthreads();
}

__device__ __forceinline__ void phase_prep(const Args& a, LAS unsigned char* lds) {
    const float* x = a.in[0]; const float* nmw = a.in[1];
    const float* w_in0 = a.in[3]; const float* a_log = a.in[5]; const float* dt_bias = a.in[6];
    unsigned char* ws = a.ws;
    LAS float* Wg8 = (LAS float*)lds;
    LAS float* tile = (LAS float*)(lds + 32768);
    const int tid = threadIdx.x, lane = tid & 63, wave = tid >> 6;
    for (int i = tid; i < 1024 * 8; i += NTHREADS) { const int k = i >> 3, j = i & 7; Wg8[i] = w_in0[(size_t)k * EVEN_IN + 2048 + j] * nmw[k]; }
    __syncthreads();
    float* RS = (float*)(ws + WS_RS); float* GATES = (float*)(ws + WS_GATES); bf16_t* XB = (bf16_t*)(ws + WS_XB);
    for (int m = blockIdx.x * NWAVES + wave; m < NTOK; m += gridDim.x * NWAVES) {
        const float4* xr = (const float4*)(x + (size_t)m * D_MODEL) + lane;
        float4 v[4]; float s = 0.f;
#pragma unroll
        for (int j = 0; j < 4; ++j) { v[j] = xr[64 * j]; s += v[j].x * v[j].x + v[j].y * v[j].y + v[j].z * v[j].z + v[j].w * v[j].w; }
        s = wave_sum(s);
        const float rs = rsqrtf(s * (1.0f / D_MODEL) + 1e-6f);
        float g[8];
#pragma unroll
        for (int q = 0; q < 8; ++q) g[q] = 0.f;
#pragma unroll
        for (int j = 0; j < 4; ++j) {
            const float xv[4] = {v[j].x, v[j].y, v[j].z, v[j].w};
#pragma unroll
            for (int e = 0; e < 4; ++e) { const int k = 256 * j + 4 * lane + e;
#pragma unroll
                for (int q = 0; q < 8; ++q) g[q] = fmaf(xv[e], Wg8[k * 8 + q], g[q]); }
            u32x2 o; o.x = g8::cvt_pk_bf16(v[j].x, v[j].y); o.y = g8::cvt_pk_bf16(v[j].z, v[j].w);
            *((u32x2*)(XB + (size_t)m * D_MODEL) + lane + 64 * j) = o;
        }
#pragma unroll
        for (int q = 0; q < 8; ++q) g[q] = wave_sum(g[q]) * rs;
        if (lane == 0) {
            RS[m] = rs;
#pragma unroll
            for (int h = 0; h < 4; ++h) { GATES[(size_t)m * 8 + h] = sigmoidf_(g[h]); GATES[(size_t)m * 8 + 4 + h] = -__expf(a_log[h]) * softplusf_(g[4 + h] + dt_bias[h]); }
        }
    }
    if (blockIdx.x == 0 && tid < 64) ((int*)(ws + WS_CNT))[tid] = 0;
    constexpr int I0 = 16 * 64, I1 = 16 * 16;
    for (int it = blockIdx.x; it < I0 + I1; it += gridDim.x) {
        int r = it;
        if (r < I0) { const int k0 = (r / 64) * 64, n0 = (r % 64) * 64; conv_tile(w_in0, EVEN_IN, n0 + (n0 >= 2048 ? 8 : 0), nmw, (bf16_t*)(ws + WS_WIN0), 1024, k0, n0, tile); continue; } r -= I0;
        if (r < I1) { const int k0 = (r / 16) * 64, n0 = (r % 16) * 64; conv_tile(a.in[10], 1024, n0, nullptr, (bf16_t*)(ws + WS_WOUT0), 1024, k0, n0, tile); continue; } r -= I1;
    }
}
__device__ __forceinline__ void odd_weight_items(const Args& a, LAS unsigned char* lds) {
    unsigned char* ws = a.ws; const float* nmw = a.in[1];
    LAS float* tile = (LAS float*)lds;
    constexpr int I2 = 16 * 96, I3 = 32 * 16;
    for (int it = blockIdx.x; it < I2 + I3; it += gridDim.x) {
        int r = it;
        if (r < I2) { const int k0 = (r / 96) * 64, n0 = (r % 96) * 64; conv_tile(a.in[11], ODD_IN, n0, nmw + 1024, (bf16_t*)(ws + WS_WIN1), 1024, k0, n0, tile); continue; } r -= I2;
        { const int k0 = (r / 16) * 64, n0 = (r % 16) * 64; conv_tile(a.in[13], 1024, n0, nullptr, (bf16_t*)(ws + WS_WOUT1), 2048, k0, n0, tile); }
    }
}

__device__ __forceinline__ void phase_post0(const Args& a) {
    unsigned char* ws = a.ws;
    bf16_t* O = (bf16_t*)(ws + WS_O0);
    const bf16_t* Gz = (const bf16_t*)(ws + WS_P + 3 * GRP0); const bf16_t* Hg = (const bf16_t*)(ws + WS_P + 7 * GRP0);
    const float* gnw = a.in[7]; const float* hnw = a.in[9];
    const int lane = threadIdx.x & 63, wave = threadIdx.x >> 6;
    const int hd = lane >> 3;
    const float* nw = hd < 4 ? gnw : hnw;
    for (int m = blockIdx.x * NWAVES + wave; m < NTOK; m += gridDim.x * NWAVES) {
        const u32x4* op = (const u32x4*)(O + (size_t)m * 1024 + 16 * lane);
        const bf16_t* zsrc = hd < 4 ? Gz + (size_t)m * 512 + 16 * lane : Hg + (size_t)m * 512 + 16 * lane - 512;
        const u32x4 o0 = op[0], o1 = op[1]; const u32x4 z0 = ((const u32x4*)zsrc)[0], z1 = ((const u32x4*)zsrc)[1];
        const unsigned ow[8] = {o0.x, o0.y, o0.z, o0.w, o1.x, o1.y, o1.z, o1.w}; const unsigned zw[8] = {z0.x, z0.y, z0.z, z0.w, z1.x, z1.y, z1.z, z1.w};
        float v[16], z[16]; float s = 0.f;
#pragma unroll
        for (int i = 0; i < 8; ++i) { v[2 * i] = __uint_as_float(ow[i] << 16); v[2 * i + 1] = __uint_as_float(ow[i] & 0xffff0000u); z[2 * i] = __uint_as_float(zw[i] << 16); z[2 * i + 1] = __uint_as_float(zw[i] & 0xffff0000u); }
#pragma unroll
        for (int i = 0; i < 16; ++i) s += v[i] * v[i];
        s += __shfl_xor(s, 1); s += __shfl_xor(s, 2); s += __shfl_xor(s, 4);
        const float rs = rsqrtf(s * (1.f / 128.f) + 1e-6f);
        unsigned r[8];
#pragma unroll
        for (int i = 0; i < 8; ++i) { const int c0 = (16 * lane + 2 * i) & 127;
            r[i] = g8::cvt_pk_bf16(v[2 * i] * rs * nw[c0] * siluf_(z[2 * i]), v[2 * i + 1] * rs * nw[c0 + 1] * siluf_(z[2 * i + 1])); }
        u32x4* wp = (u32x4*)(O + (size_t)m * 1024 + 16 * lane);
        wp[0] = (u32x4){r[0], r[1], r[2], r[3]}; wp[1] = (u32x4){r[4], r[5], r[6], r[7]};
    }
}

template <bool FINAL>
__device__ __forceinline__ void phase_moe_simple(const Args& a, int layer, LAS unsigned char* lds) {
    unsigned char* ws = a.ws;
    float* xio = a.out;
    const float* nw = a.in[2] + layer * 1024; const float* wc = a.in[14] + layer * 1024 * 4; const float* bc = a.in[15] + layer * 4;
    const float* wf = a.in[16] + layer * 1024 * 16; const float* bfp = a.in[17] + layer * 16;
    const float* wgu = a.in[18] + (size_t)layer * 16 * 1024 * 512; const float* wd = a.in[19] + (size_t)layer * 16 * 256 * 1024;
    const float* fw = a.in[20];
    bf16_t* XB = (bf16_t*)(ws + WS_XB); float* RS = (float*)(ws + WS_RS);
    LAS float* hs = (LAS float*)lds; LAS float* gu = hs + 1024; LAS float* actv = gu + 512; LAS float* red = actv + 256; LAS float* logits = red + 16; LAS float* selw = logits + 32; LAS int* sele = (LAS int*)(selw + 4);
    const int t = threadIdx.x;
    for (int tok = blockIdx.x; tok < NTOK; tok += gridDim.x) {
        float xv0 = xio[(size_t)tok * 1024 + t], xv1 = xio[(size_t)tok * 1024 + 512 + t];
        float s = wave_sum(xv0 * xv0 + xv1 * xv1);
        __syncthreads();
        if ((t & 63) == 0) red[t >> 6] = s;
        __syncthreads();
        s = 0.f;
#pragma unroll
        for (int i = 0; i < 8; ++i) s += red[i];
        const float rs = rsqrtf(s * (1.0f / D_MODEL) + 1e-6f);
        hs[t] = xv0 * rs * nw[t]; hs[512 + t] = xv1 * rs * nw[512 + t];
        __syncthreads();
        if (t < 20) {
            float acc = 0.f;
            if (t < 4) { for (int k = 0; k < 1024; ++k) acc = fmaf(hs[k], wc[k * 4 + t], acc); acc += bc[t]; }
            else { const int e = t - 4; for (int k = 0; k < 1024; ++k) acc = fmaf(hs[k], wf[k * 16 + e], acc); acc += bfp[e]; }
            logits[t] = acc;
        }
        __syncthreads();
        if (t == 0) {
            float mx = logits[0]; int gi = 0;
            for (int i = 1; i < 4; ++i) if (logits[i] > mx) { mx = logits[i]; gi = i; }
            float den = 0.f;
            for (int i = 0; i < 4; ++i) den += __expf(logits[i] - mx);
            const float gprob = 1.f / den;
            float f0 = logits[4 + gi * 4], f1 = logits[5 + gi * 4], f2 = logits[6 + gi * 4], f3 = logits[7 + gi * 4];
            const float fl[4] = {f0, f1, f2, f3};
            int e0 = 0; float m0 = fl[0];
            for (int i = 1; i < 4; ++i) if (fl[i] > m0) { m0 = fl[i]; e0 = i; }
            int e1 = -1; float m1 = -3.0e38f;
            for (int i = 0; i < 4; ++i) if (i != e0 && fl[i] > m1) { m1 = fl[i]; e1 = i; }
            const float p1 = __expf(m1 - m0);
            sele[0] = gi * 4 + e0; sele[1] = gi * 4 + e1;
            selw[0] = gprob / (1.f + p1); selw[1] = gprob * p1 / (1.f + p1);
        }
        __syncthreads();
        float o0 = 0.f, o1 = 0.f;
        for (int s2 = 0; s2 < 2; ++s2) {
            const int e = sele[s2]; const float gw = selw[s2];
            const float* W = wgu + (size_t)e * 1024 * 512;
            float g = 0.f;
            for (int k = 0; k < 1024; ++k) g = fmaf(hs[k], W[(size_t)k * 512 + t], g);
            gu[t] = g;
            __syncthreads();
            if (t < 256) actv[t] = siluf_(gu[t]) * gu[256 + t] * gw;
            __syncthreads();
            const float* Wd = wd + (size_t)e * 256 * 1024;
            for (int f = 0; f < 256; ++f) { const float av = actv[f]; o0 = fmaf(av, Wd[(size_t)f * 1024 + t], o0); o1 = fmaf(av, Wd[(size_t)f * 1024 + 512 + t], o1); }
        }
        xv0 += o0; xv1 += o1;
        float s3 = wave_sum(xv0 * xv0 + xv1 * xv1);
        __syncthreads();
        if ((t & 63) == 0) red[t >> 6] = s3;
        __syncthreads();
        s3 = 0.f;
#pragma unroll
        for (int i = 0; i < 8; ++i) s3 += red[i];
        const float rs2 = rsqrtf(s3 * (1.0f / D_MODEL) + 1e-6f);
        if (FINAL) { xio[(size_t)tok * 1024 + t] = xv0 * rs2 * fw[t]; xio[(size_t)tok * 1024 + 512 + t] = xv1 * rs2 * fw[512 + t]; }
        else {
            xio[(size_t)tok * 1024 + t] = xv0; xio[(size_t)tok * 1024 + 512 + t] = xv1;
            XB[(size_t)tok * 1024 + t] = (bf16_t)(g8::cvt_pk_bf16(xv0, 0.f) & 0xffffu); XB[(size_t)tok * 1024 + 512 + t] = (bf16_t)(g8::cvt_pk_bf16(xv1, 0.f) & 0xffffu);
            if (t == 0) RS[tok] = rs2;
        }
    }
}


__device__ __forceinline__ void moe_weight_items(const Args& a, int layer, LAS unsigned char* lds) {
    unsigned char* ws = a.ws;
    LAS float* tile = (LAS float*)lds;
    const float* wgu = a.in[18] + (size_t)layer * 16 * 1024 * 512; const float* wd = a.in[19] + (size_t)layer * 16 * 256 * 1024;
    const float* nw = a.in[2] + layer * 1024;
    constexpr int IG = 16 * 16 * 8, ID = 24 * 2 * 4 * 16;
    for (int it = blockIdx.x; it < IG + ID; it += gridDim.x) {
        if (it < IG) { const int e = it >> 7, r = it & 127, k0 = (r >> 3) * 64, n0 = (r & 7) * 64;
            const int u = n0 >> 8, hf = (n0 >> 7) & 1, j0 = n0 & 127;
            conv_tile(wgu + (size_t)e * 1024 * 512, 512, hf * 256 + u * 128 + j0, nw, (bf16_t*)(ws + WS_WGU) + (size_t)e * 512 * 1024, 1024, k0, n0, tile);
        } else { const int r = it - IG; const int bkt = r >> 7, q = r & 127, slot = q >> 6, kt = (q >> 4) & 3, n0 = (q & 15) * 64;
            const int g = bkt / 6, pr = bkt % 6; const int ei = pr < 3 ? 0 : (pr < 5 ? 1 : 2), ej = pr < 3 ? pr + 1 : (pr < 5 ? pr - 1 : 3);
            const int e = g * 4 + (slot ? ej : ei);
            conv_tile(wd + (size_t)e * 256 * 1024, 1024, n0, nullptr, (bf16_t*)(ws + WS_WDN) + (size_t)bkt * 1024 * 512, 512, slot * 256 + kt * 64, n0, tile, kt * 64);
        }
    }
}

__device__ __forceinline__ void phase_route(const Args& a, int layer, LAS unsigned char* lds) {
    unsigned char* ws = a.ws;
    const float* x = a.out;
    const float* nw = a.in[2] + layer * 1024; const float* wc = a.in[14] + layer * 1024 * 4; const float* bc = a.in[15] + layer * 4;
    const float* wf = a.in[16] + layer * 1024 * 16; const float* bfp = a.in[17] + layer * 16;
    int* cnt = (int*)(ws + WS_CNT) + layer * 32; int4* rec = (int4*)(ws + WS_ROWREC);
    LAS g8::f32x4* W20 = (LAS g8::f32x4*)lds;
    const int tid = threadIdx.x, lane = tid & 63, wave = tid >> 6;
    for (int i = tid; i < 5 * 1024; i += NTHREADS) { const int p = i >> 10, k = i & 1023; const float w = nw[k];
        g8::f32x4 v; if (p == 0) { v = (g8::f32x4){wc[k * 4] * w, wc[k * 4 + 1] * w, wc[k * 4 + 2] * w, wc[k * 4 + 3] * w}; }
        else { const float* q = wf + k * 16 + (p - 1) * 4; v = (g8::f32x4){q[0] * w, q[1] * w, q[2] * w, q[3] * w}; }
        W20[i] = v; }
    __syncthreads();
    for (int m = blockIdx.x * NWAVES + wave; m < NTOK; m += gridDim.x * NWAVES) {
        const float* xr = x + (size_t)m * D_MODEL + lane;
        float acc[20];
#pragma unroll
        for (int j = 0; j < 20; ++j) acc[j] = 0.f;
        float s = 0.f;
#pragma unroll 2
        for (int i = 0; i < 16; ++i) { const float xv = xr[64 * i]; s = fmaf(xv, xv, s); const int k = 64 * i + lane;
#pragma unroll
            for (int p = 0; p < 5; ++p) { const g8::f32x4 w = W20[p * 1024 + k]; acc[4 * p] = fmaf(xv, w[0], acc[4 * p]); acc[4 * p + 1] = fmaf(xv, w[1], acc[4 * p + 1]); acc[4 * p + 2] = fmaf(xv, w[2], acc[4 * p + 2]); acc[4 * p + 3] = fmaf(xv, w[3], acc[4 * p + 3]); } }
        s = wave_sum(s);
        const float rs = rsqrtf(s * (1.0f / D_MODEL) + 1e-6f);
#pragma unroll
        for (int j = 0; j < 20; ++j) acc[j] = wave_sum(acc[j]) * rs;
        if (lane == 0) {
            float c0 = acc[0] + bc[0], c1 = acc[1] + bc[1], c2 = acc[2] + bc[2], c3 = acc[3] + bc[3];
            int gi = 0; float mx = c0; if (c1 > mx) { mx = c1; gi = 1; } if (c2 > mx) { mx = c2; gi = 2; } if (c3 > mx) { mx = c3; gi = 3; }
            const float gprob = 1.f / (__expf(c0 - mx) + __expf(c1 - mx) + __expf(c2 - mx) + __expf(c3 - mx));
            float f0, f1, f2, f3;
            if (gi == 0) { f0 = acc[4]; f1 = acc[5]; f2 = acc[6]; f3 = acc[7]; } else if (gi == 1) { f0 = acc[8]; f1 = acc[9]; f2 = acc[10]; f3 = acc[11]; }
            else if (gi == 2) { f0 = acc[12]; f1 = acc[13]; f2 = acc[14]; f3 = acc[15]; } else { f0 = acc[16]; f1 = acc[17]; f2 = acc[18]; f3 = acc[19]; }
            f0 += bfp[gi * 4]; f1 += bfp[gi * 4 + 1]; f2 += bfp[gi * 4 + 2]; f3 += bfp[gi * 4 + 3];
            int e0 = 0; float m0 = f0; if (f1 > m0) { m0 = f1; e0 = 1; } if (f2 > m0) { m0 = f2; e0 = 2; } if (f3 > m0) { m0 = f3; e0 = 3; }
            int e1 = -1; float m1 = -3.0e38f;
            if (e0 != 0 && f0 > m1) { m1 = f0; e1 = 0; } if (e0 != 1 && f1 > m1) { m1 = f1; e1 = 1; } if (e0 != 2 && f2 > m1) { m1 = f2; e1 = 2; } if (e0 != 3 && f3 > m1) { m1 = f3; e1 = 3; }
            const float p1 = __expf(m1 - m0);
            const float w0 = gprob / (1.f + p1), w1 = gprob * p1 / (1.f + p1);
            const int lo = e0 < e1 ? e0 : e1, hi = e0 < e1 ? e1 : e0;
            const float wlo = e0 < e1 ? w0 : w1, whi = e0 < e1 ? w1 : w0;
            const int pr = lo == 0 ? hi - 1 : (lo == 1 ? hi + 1 : 5);
            const int bkt = gi * 6 + pr;
            const int pos = atomicAdd(cnt + bkt, 1);
            rec[(size_t)bkt * NTOK + pos] = make_int4(m, __float_as_int(rs), __float_as_int(wlo), __float_as_int(whi));
        }
    }
}

__device__ __forceinline__ void moe_table(const Args& a, int layer, LAS unsigned char* lds) {
    LAS int* tab = (LAS int*)(lds + LDS_TAB);
    const int* cnt = (const int*)(a.ws + WS_CNT) + layer * 32;
    if (threadIdx.x == 0) { int p = 0; for (int b = 0; b < 24; ++b) { const int c = __hip_atomic_load(cnt + b, __ATOMIC_RELAXED, __HIP_MEMORY_SCOPE_AGENT); tab[b] = p; tab[32 + b] = c; p += (c + 255) >> 8; } tab[24] = p; }
    __syncthreads();
}

namespace g8 {
struct MoeOrder {
    const char* A; const char* B; const int4* rec; G8_LAS const int* tab; int mode, G, c;
    __device__ __forceinline__ bool next(int i, Unit& u) const {
        const int L = i * G + c; if (L >= __builtin_amdgcn_readfirstlane(tab[24]) * 4) return false;
        const int p = L >> 2, pn = L & 3;
        int b = 0;
        for (int j = 1; j < 24; ++j) { const int tj = __builtin_amdgcn_readfirstlane(tab[j]); if (tj <= p) b = j; }
        const int pib = p - __builtin_amdgcn_readfirstlane(tab[b]); int nv = __builtin_amdgcn_readfirstlane(tab[32 + b]) - pib * 256; nv = nv > 256 ? 256 : nv;
        u.pm = p; u.pn = pn; u.aux0 = b * NTOK + pib * 256; u.aux1 = nv;
        if (mode == 0) { const int g = b / 6, pr = b % 6; const int ei = pr < 3 ? 0 : (pr < 5 ? 1 : 2), ej = pr < 3 ? pr + 1 : (pr < 5 ? pr - 1 : 3);
            const int e = g * 4 + ((pn >> 1) ? ej : ei);
            u.a = A; u.b = B + ((size_t)e * 512 + (pn & 1) * 256) * 2048; }
        else { u.a = A + (size_t)p * 256 * 1024; u.b = B + ((size_t)b * 1024 + pn * 256) * 1024; }
        return true;
    }
    __device__ __forceinline__ unsigned rowoff(const Unit& u, int r) const { const int tok = r < u.aux1 ? rec[u.aux0 + r].x : 0; return (unsigned)tok * 2048u; }
};
struct EpiGU {
    bf16_t* act; const int4* rec;
    __device__ __forceinline__ void operator()(const f32x4 (&acc)[2][2][4][2], const Unit& u, int wr, int wc, int fr, int fq) const {
        const int slot = u.pn >> 1; const int colb = slot * 256 + (u.pn & 1) * 128 + wc * 32 + 8 * fq;
#pragma unroll
        for (int ai = 0; ai < 2; ++ai)
#pragma unroll
            for (int m = 0; m < 4; ++m) { const int r = ai * HALF + wr * 64 + m * 16 + fr;
                if (r < u.aux1) { const int4 rc = rec[u.aux0 + r]; const float rs = __int_as_float(rc.y), w = __int_as_float(slot ? rc.w : rc.z);
                    float v[8];
#pragma unroll
                    for (int n = 0; n < 2; ++n)
#pragma unroll
                        for (int e = 0; e < 4; ++e) { const float g = acc[ai][0][m][n][e] * rs, up = acc[ai][1][m][n][e] * rs; v[4 * n + e] = g / (1.0f + __expf(-g)) * up * w; }
                    u32x4 o; o.x = cvt_pk_bf16(v[0], v[1]); o.y = cvt_pk_bf16(v[2], v[3]); o.z = cvt_pk_bf16(v[4], v[5]); o.w = cvt_pk_bf16(v[6], v[7]);
                    *(u32x4*)(act + ((size_t)u.pm * 256 + r) * 512 + colb) = o; }
                asm volatile("" ::: "memory"); }
    }
};
struct EpiDown {
    float* xio; bf16_t* xb; float* rowss; const int4* rec;
    __device__ __forceinline__ void operator()(const f32x4 (&acc)[2][2][4][2], const Unit& u, int wr, int wc, int fr, int fq) const {
        const int col0 = u.pn * BM + wc * 32 + 8 * fq;
#pragma unroll
        for (int ai = 0; ai < 2; ++ai)
#pragma unroll
            for (int m = 0; m < 4; ++m) { const int r = ai * HALF + wr * 64 + m * 16 + fr; const bool valid = r < u.aux1;
                float ss = 0.f; int tok = 0;
                if (valid) { tok = rec[u.aux0 + r].x; const size_t ro = (size_t)tok * 1024 + col0;
#pragma unroll
                    for (int bj = 0; bj < 2; ++bj) {
                        const f32x4 r0 = *(const f32x4*)(xio + ro + bj * HALF), r1 = *(const f32x4*)(xio + ro + bj * HALF + 4);
                        const f32x4 v0 = acc[ai][bj][m][0] + r0, v1 = acc[ai][bj][m][1] + r1;
                        *(f32x4*)(xio + ro + bj * HALF) = v0; *(f32x4*)(xio + ro + bj * HALF + 4) = v1;
                        ss += v0[0] * v0[0] + v0[1] * v0[1] + v0[2] * v0[2] + v0[3] * v0[3] + v1[0] * v1[0] + v1[1] * v1[1] + v1[2] * v1[2] + v1[3] * v1[3];
                        u32x4 w; w.x = cvt_pk_bf16(v0[0], v0[1]); w.y = cvt_pk_bf16(v0[2], v0[3]); w.z = cvt_pk_bf16(v1[0], v1[1]); w.w = cvt_pk_bf16(v1[2], v1[3]);
                        *(u32x4*)(xb + ro + bj * HALF) = w; } }
                ss += __shfl_xor(ss, 16); ss += __shfl_xor(ss, 32);
                if (valid && fq == 0) rowss[(size_t)tok * 16 + u.pn * 4 + wc] = ss;
                asm volatile("" ::: "memory"); }
    }
};
}

__device__ __forceinline__ void phase_final(const Args& a) {
    float* x = a.out; const float* fw = a.in[20]; const float* rowss = (const float*)(a.ws + WS_ROWSS) + (size_t)NTOK * 16;
    const int lane = threadIdx.x & 63, wave = threadIdx.x >> 6;
    for (int m = blockIdx.x * NWAVES + wave; m < NTOK; m += gridDim.x * NWAVES) {
        float ssum = 0.f;
        { const g8::f32x4* pp = (const g8::f32x4*)(rowss + (size_t)m * 16);
#pragma unroll
          for (int q4 = 0; q4 < 4; ++q4) { const g8::f32x4 t4 = pp[q4]; ssum += (t4[0] + t4[1]) + (t4[2] + t4[3]); } }
        const float rs = rsqrtf(ssum * (1.0f / D_MODEL) + 1e-6f);
        float4* xr = (float4*)(x + (size_t)m * D_MODEL) + lane;
#pragma unroll
        for (int j = 0; j < 4; ++j) { float4 v = xr[64 * j]; const float4 w = ((const float4*)fw)[lane + 64 * j]; v.x *= rs * w.x; v.y *= rs * w.y; v.z *= rs * w.z; v.w *= rs * w.w; xr[64 * j] = v; }
    }
}

typedef g8::bf16x8 bf16x8;
typedef g8::f32x4 f32x4;
__device__ __forceinline__ f32x4 mfma16(bf16x8 a, bf16x8 b, f32x4 c) { return __builtin_amdgcn_mfma_f32_16x16x32_bf16(a, b, c, 0, 0, 0); }

__device__ __forceinline__ void phase_ret_prep(const Args& a, LAS unsigned char* lds) {
    unsigned char* ws = a.ws;
    bf16_t* PQ = (bf16_t*)(ws + WS_PQ); bf16_t* PK = (bf16_t*)(ws + WS_PK); bf16_t* ATT = (bf16_t*)(ws + WS_WIN0);
    LAS unsigned char* QXs = lds; LAS unsigned char* KDs = lds + 33792; LAS unsigned char* KDTs = lds + 67584; LAS unsigned char* ATs = lds + 104448;
    LAS float* invs = (LAS float*)(lds + 113664);
    int tid_ = threadIdx.x; asm volatile("" : "+v"(tid_)); const int tid = tid_, lane = tid & 63, w = tid >> 6, fr = lane & 15, fq = lane >> 4;
    if (tid < 128) invs[tid] = 1.0f / powf(10000.0f, (float)tid / 127.0f);
    __syncthreads();
    for (int it = blockIdx.x; it < 1024; it += gridDim.x) {
        const int h = (it >> 6) & 3, n = it & 63;
        const float lg = log2f(1.0f - exp2f(-5.0f - (float)h));
        {
            const int tok = tid >> 3, p0 = (tid & 7) * 16;
            const float pos = (float)(n * 64 + tok);
            const float sq = exp2f((float)(tok + 1) * lg), sk = exp2f((float)(63 - tok) * lg) * 0.0625f;
            const u32x4* qsrc = (const u32x4*)(PQ + (size_t)it * 16384 + tok * 256 + 2 * p0); const u32x4* ksrc = (const u32x4*)(PK + (size_t)it * 16384 + tok * 256 + 2 * p0);
#pragma unroll
            for (int q4 = 0; q4 < 4; ++q4) { const u32x4 qv = qsrc[q4], kv = ksrc[q4]; const unsigned qw[4] = {qv.x, qv.y, qv.z, qv.w}, kw[4] = {kv.x, kv.y, kv.z, kv.w};
                unsigned qo[4], ko[4];
#pragma unroll
                for (int e = 0; e < 4; ++e) { const int p = p0 + q4 * 4 + e; float sn, cs; sincosf(pos * invs[p], &sn, &cs);
                    const float q1 = __uint_as_float(qw[e] << 16), q2 = __uint_as_float(qw[e] & 0xffff0000u), k1 = __uint_as_float(kw[e] << 16), k2 = __uint_as_float(kw[e] & 0xffff0000u);
                    qo[e] = g8::cvt_pk_bf16((q1 * cs - q2 * sn) * sq, (q1 * sn + q2 * cs) * sq); ko[e] = g8::cvt_pk_bf16((k1 * cs - k2 * sn) * sk, (k1 * sn + k2 * cs) * sk);
                    *(LAS unsigned short*)(KDTs + (2 * p) * 144 + tok * 2) = (unsigned short)(ko[e] & 0xffffu); *(LAS unsigned short*)(KDTs + (2 * p + 1) * 144 + tok * 2) = (unsigned short)(ko[e] >> 16); }
                *(LAS u32x4*)(QXs + tok * 528 + (2 * p0 + 8 * q4) * 2) = (u32x4){qo[0], qo[1], qo[2], qo[3]}; *(LAS u32x4*)(KDs + tok * 528 + (2 * p0 + 8 * q4) * 2) = (u32x4){ko[0], ko[1], ko[2], ko[3]}; }
        }
        __syncthreads();
        {
            const int rt = w >> 1; const float ig = exp2f(-64.0f * lg);
#pragma unroll
            for (int c2 = 0; c2 < 2; ++c2) { const int ct = 2 * (w & 1) + c2; f32x4 acc = (f32x4){0.f, 0.f, 0.f, 0.f};
                if (ct <= rt) {
#pragma unroll
                    for (int ks = 0; ks < 8; ++ks) { const bf16x8 af = *(const LAS bf16x8*)(QXs + (16 * rt + fr) * 528 + (32 * ks + 8 * fq) * 2); const bf16x8 bf = *(const LAS bf16x8*)(KDs + (16 * ct + fr) * 528 + (32 * ks + 8 * fq) * 2);
                        acc = mfma16(bf, af, acc); } }
                const int i = 16 * rt + fr; float v[4];
#pragma unroll
                for (int e = 0; e < 4; ++e) { const int j = 16 * ct + 4 * fq + e; v[e] = (j <= i) ? acc[e] * ig : 0.f; }
                *(LAS u32x2*)(ATs + i * 144 + (16 * ct + 4 * fq) * 2) = (u32x2){g8::cvt_pk_bf16(v[0], v[1]), g8::cvt_pk_bf16(v[2], v[3])}; }
        }
        __syncthreads();
        {
            u32x4* qdst = (u32x4*)(PQ + (size_t)it * 16384); u32x4* kdst = (u32x4*)(PK + (size_t)it * 16384); u32x4* adst = (u32x4*)(ATT + (size_t)it * 4096);
#pragma unroll
            for (int i = 0; i < 4; ++i) { const int q = tid + 512 * i, tile = q >> 6, l = q & 63;
                { const int rt = tile >> 3, ks = tile & 7; qdst[q] = *(const LAS u32x4*)(QXs + (16 * rt + (l & 15)) * 528 + (32 * ks + 8 * (l >> 4)) * 2); }
                { const int rt = tile >> 1, ks = tile & 1; kdst[q] = *(const LAS u32x4*)(KDTs + (16 * rt + (l & 15)) * 144 + (32 * ks + 8 * (l >> 4)) * 2); } }
            { const int tile = tid >> 6, l = tid & 63; const int rt = tile >> 1, ks = tile & 1; adst[tid] = *(const LAS u32x4*)(ATs + (16 * rt + (l & 15)) * 144 + (32 * ks + 8 * (l >> 4)) * 2); }
        }
        __syncthreads();
    }
}

__device__ __forceinline__ void phase_ret_scan(const Args& a, LAS unsigned char* lds) {
    unsigned char* ws = a.ws;
    const bf16_t* QX = (const bf16_t*)(ws + WS_PQ); const bf16_t* KDT = (const bf16_t*)(ws + WS_PK); const bf16_t* ATT = (const bf16_t*)(ws + WS_WIN0); bf16_t* PV = (bf16_t*)(ws + WS_PV);
    int tid_ = threadIdx.x; asm volatile("" : "+v"(tid_)); const int tid = tid_, lane = tid & 63, w = __builtin_amdgcn_readfirstlane(tid >> 6), fr = lane & 15, fq = lane >> 4;
    for (int it = blockIdx.x; it < 256; it += gridDim.x) {
        const int bh = (it & 7) | ((it >> 7) << 3), sl = (it >> 3) & 15, b = bh >> 2, h = bh & 3;
        const float cdec = exp2f(64.0f * log2f(1.0f - exp2f(-5.0f - (float)h)));
        const int rt = w >> 1, cto = w & 1;
        f32x4 sacc[2][2];
#pragma unroll
        for (int r = 0; r < 2; ++r)
#pragma unroll
            for (int c = 0; c < 2; ++c) sacc[r][c] = (f32x4){0.f, 0.f, 0.f, 0.f};
        const int vtok = tid >> 3, vdv = (tid & 7) * 4;
        bf16_t* vbase = PV + ((size_t)b * SEQ) * 2048 + h * 512 + sl * 32;
        for (int n = 0; n < 64; ++n) {
            const size_t blk = (size_t)bh * 64 + n;
            const bf16x8* qb = (const bf16x8*)(QX + blk * 16384) + lane; const bf16x8* kb = (const bf16x8*)(KDT + blk * 16384) + lane; const bf16x8* ab = (const bf16x8*)(ATT + blk * 4096) + lane;
            bf16x8 qf[8], af[2], kf[2][2];
#pragma unroll
            for (int ks = 0; ks < 8; ++ks) qf[ks] = qb[(rt * 8 + ks) * 64];
#pragma unroll
            for (int k2 = 0; k2 < 2; ++k2) af[k2] = ab[(rt * 2 + k2) * 64];
#pragma unroll
            for (int r = 0; r < 2; ++r)
#pragma unroll
                for (int k2 = 0; k2 < 2; ++k2) kf[r][k2] = kb[((2 * w + r) * 2 + k2) * 64];
            const u32x2 vv = *(const u32x2*)(vbase + (size_t)(n * 64 + vtok) * 2048 + vdv);
            LAS unsigned char* STs = lds + (n & 1) * 16896;
            LAS unsigned char* VTs = lds + 33792 + (n & 1) * 4608;
#pragma unroll
            for (int r = 0; r < 2; ++r)
#pragma unroll
                for (int c = 0; c < 2; ++c) { const f32x4 v = sacc[r][c];
                    *(LAS u32x2*)(STs + (16 * c + fr) * 528 + (16 * (2 * w + r) + 4 * fq) * 2) = (u32x2){g8::cvt_pk_bf16(v[0], v[1]), g8::cvt_pk_bf16(v[2], v[3])}; }
            *(LAS unsigned short*)(VTs + (vdv + 0) * 144 + vtok * 2) = (unsigned short)(vv.x & 0xffffu); *(LAS unsigned short*)(VTs + (vdv + 1) * 144 + vtok * 2) = (unsigned short)(vv.x >> 16);
            *(LAS unsigned short*)(VTs + (vdv + 2) * 144 + vtok * 2) = (unsigned short)(vv.y & 0xffffu); *(LAS unsigned short*)(VTs + (vdv + 3) * 144 + vtok * 2) = (unsigned short)(vv.y >> 16);
            __syncthreads();
            f32x4 o = (f32x4){0.f, 0.f, 0.f, 0.f};
#pragma unroll
            for (int ks = 0; ks < 8; ++ks) { const bf16x8 sb = *(const LAS bf16x8*)(STs + (16 * cto + fr) * 528 + (32 * ks + 8 * fq) * 2); o = mfma16(sb, qf[ks], o); }
            bf16x8 vb[2][2];
#pragma unroll
            for (int c = 0; c < 2; ++c)
#pragma unroll
                for (int k2 = 0; k2 < 2; ++k2) vb[c][k2] = *(const LAS bf16x8*)(VTs + (16 * c + fr) * 144 + (32 * k2 + 8 * fq) * 2);
#pragma unroll
            for (int k2 = 0; k2 < 2; ++k2) o = mfma16(vb[cto][k2], af[k2], o);
#pragma unroll
            for (int r = 0; r < 2; ++r)
#pragma unroll
                for (int c = 0; c < 2; ++c) { f32x4 t = sacc[r][c] * cdec;
#pragma unroll
                    for (int k2 = 0; k2 < 2; ++k2) t = mfma16(kf[r][k2], vb[c][k2], t);
                    sacc[r][c] = t; }
            *(u32x2*)(vbase + (size_t)(n * 64 + 16 * rt + fr) * 2048 + 16 * cto + 4 * fq) = (u32x2){g8::cvt_pk_bf16(o[0], o[1]), g8::cvt_pk_bf16(o[2], o[3])};
        }
        __syncthreads();
    }
}


__device__ __forceinline__ void hgrn_prep_item(const Args& a, LAS unsigned char* lds, const int it) {
    unsigned char* ws = a.ws;
    bf16_t* HQ = (bf16_t*)(ws + WS_P + 4 * GRP0); bf16_t* HF = (bf16_t*)(ws + WS_P + 5 * GRP0); bf16_t* ATT = (bf16_t*)(ws + WS_HATT); float* DEC = (float*)(ws + WS_HDEC);
    const float* lbl = a.in[8];
    LAS unsigned char* QXs = lds; LAS unsigned char* QAs = lds + 17408; LAS unsigned char* KAs = lds + 34816; LAS unsigned char* KDTs = lds + 52224; LAS unsigned char* ATs = lds + 70656;
    LAS float* tot = (LAS float*)(lds + 79872);
    int tid_ = threadIdx.x; asm volatile("" : "+v"(tid_)); const int tid = tid_, lane = tid & 63, w = tid >> 6, fr = lane & 15, fq = lane >> 4;
    const int seg = tid >> 7, c = tid & 127;
    {
        const int h = (it >> 6) & 3;
        float lb;
        { const int ch = h * 128 + c; const float l0 = lbl[ch], l1 = lbl[512 + ch], l2 = lbl[1024 + ch]; const float mx = fmaxf(l0, fmaxf(l1, l2));
          const float e0 = __expf(l0 - mx), e1 = __expf(l1 - mx), e2 = __expf(l2 - mx); lb = e0 / (e0 + e1 + e2); }
        const bf16_t* qsrc = HQ + (size_t)it * 8192 + c; const bf16_t* fsrc = HF + (size_t)it * 8192 + c;
        float q[16], k[16], bl[16]; float run = 0.f;
#pragma unroll
        for (int i = 0; i < 16; ++i) { const int t = 16 * seg + i; const float xq = bf2f(qsrc[t * 128]), xf = bf2f(fsrc[t * 128]);
            const float f = lb + (1.f - lb) * sigmoidf_(xf); run += __logf(f); bl[i] = run; k[i] = 1.f - f; q[i] = siluf_(xq) * 0.08838834764831845f; }
        tot[seg * 128 + c] = run;
        __syncthreads();
        const float t0 = tot[c], t1 = tot[128 + c], t2 = tot[256 + c], t3 = tot[384 + c];
        const float off = seg == 0 ? 0.f : (seg == 1 ? t0 : (seg == 2 ? t0 + t1 : t0 + t1 + t2)), rref = t0 + t1, blast = t0 + t1 + t2 + t3;
#pragma unroll
        for (int i = 0; i < 16; ++i) { const int t = 16 * seg + i; const float bt = bl[i] + off;
            const unsigned pk0 = g8::cvt_pk_bf16(q[i] * __expf(bt), q[i] * __expf(bt - rref)), pk1 = g8::cvt_pk_bf16(k[i] * __expf(rref - bt), k[i] * __expf(blast - bt));
            *(LAS unsigned short*)(QXs + t * 272 + c * 2) = (unsigned short)(pk0 & 0xffffu); *(LAS unsigned short*)(QAs + t * 272 + c * 2) = (unsigned short)(pk0 >> 16);
            *(LAS unsigned short*)(KAs + t * 272 + c * 2) = (unsigned short)(pk1 & 0xffffu); *(LAS unsigned short*)(KDTs + c * 144 + t * 2) = (unsigned short)(pk1 >> 16); }
        if (seg == 0) DEC[(size_t)it * 128 + c] = __expf(blast);
        __syncthreads();
        {   const int rt = w >> 1;
#pragma unroll
            for (int c2 = 0; c2 < 2; ++c2) { const int ct = 2 * (w & 1) + c2; f32x4 acc = (f32x4){0.f, 0.f, 0.f, 0.f};
                if (ct <= rt) {
#pragma unroll
                    for (int ks = 0; ks < 4; ++ks) { const bf16x8 af = *(const LAS bf16x8*)(QAs + (16 * rt + fr) * 272 + (32 * ks + 8 * fq) * 2); const bf16x8 bf = *(const LAS bf16x8*)(KAs + (16 * ct + fr) * 272 + (32 * ks + 8 * fq) * 2);
                        acc = mfma16(bf, af, acc); } }
                const int i = 16 * rt + fr; float v[4];
#pragma unroll
                for (int e = 0; e < 4; ++e) { const int j = 16 * ct + 4 * fq + e; v[e] = (j <= i) ? acc[e] : 0.f; }
                *(LAS u32x2*)(ATs + i * 144 + (16 * ct + 4 * fq) * 2) = (u32x2){g8::cvt_pk_bf16(v[0], v[1]), g8::cvt_pk_bf16(v[2], v[3])}; }
        }
        __syncthreads();
        {   u32x4* qdst = (u32x4*)(HQ + (size_t)it * 8192); u32x4* kdst = (u32x4*)(HF + (size_t)it * 8192); u32x4* adst = (u32x4*)(ATT + (size_t)it * 4096);
#pragma unroll
            for (int i = 0; i < 2; ++i) { const int q2 = tid + 512 * i, tile = q2 >> 6, l = q2 & 63;
                { const int rt = tile >> 2, ks = tile & 3; qdst[q2] = *(const LAS u32x4*)(QXs + (16 * rt + (l & 15)) * 272 + (32 * ks + 8 * (l >> 4)) * 2); }
                { const int rt = tile >> 1, ks = tile & 1; kdst[q2] = *(const LAS u32x4*)(KDTs + (16 * rt + (l & 15)) * 144 + (32 * ks + 8 * (l >> 4)) * 2); } }
            { const int tile = tid >> 6, l = tid & 63; const int rt = tile >> 1, ks = tile & 1; adst[tid] = *(const LAS u32x4*)(ATs + (16 * rt + (l & 15)) * 144 + (32 * ks + 8 * (l >> 4)) * 2); }
        }
        __syncthreads();
    }
}

__device__ __forceinline__ void hgrn_scan_item(const Args& a, LAS unsigned char* lds, int idx) {
    unsigned char* ws = a.ws;
    const bf16_t* QX = (const bf16_t*)(ws + WS_P + 4 * GRP0); const bf16_t* KDT = (const bf16_t*)(ws + WS_P + 5 * GRP0); const bf16_t* HI = (const bf16_t*)(ws + WS_P + 6 * GRP0);
    const bf16_t* ATT = (const bf16_t*)(ws + WS_HATT); const float* DEC = (const float*)(ws + WS_HDEC); bf16_t* O = (bf16_t*)(ws + WS_O0);
    int tid_ = threadIdx.x; asm volatile("" : "+v"(tid_)); const int tid = tid_, lane = tid & 63, w = __builtin_amdgcn_readfirstlane(tid >> 6), fr = lane & 15, fq = lane >> 4;
    const int bh = (idx & 7) | (((idx >> 5) & 1) << 3), sl = (idx >> 3) & 3, b = bh >> 2, h = bh & 3;
    const int rt = w >> 1, cto = w & 1;
    f32x4 sacc[2];
    sacc[0] = (f32x4){0.f, 0.f, 0.f, 0.f}; sacc[1] = (f32x4){0.f, 0.f, 0.f, 0.f};
    const int vtok = tid >> 3, vdv = (tid & 7) * 4;
    const bf16_t* vbase = HI + ((size_t)b * SEQ) * 512 + h * 128 + sl * 32;
    bf16_t* obase = O + ((size_t)b * SEQ) * 1024 + 512 + h * 128 + sl * 32;
    for (int n = 0; n < 64; ++n) {
        const size_t blk = (size_t)bh * 64 + n;
        const bf16x8* qb = (const bf16x8*)(QX + blk * 8192) + lane; const bf16x8* kb = (const bf16x8*)(KDT + blk * 8192) + lane; const bf16x8* ab = (const bf16x8*)(ATT + blk * 4096) + lane;
        bf16x8 qf[4], af[2], kf[2];
#pragma unroll
        for (int ks = 0; ks < 4; ++ks) qf[ks] = qb[(rt * 4 + ks) * 64];
#pragma unroll
        for (int k2 = 0; k2 < 2; ++k2) { af[k2] = ab[(rt * 2 + k2) * 64]; kf[k2] = kb[(w * 2 + k2) * 64]; }
        const f32x4 dec = *(const f32x4*)(DEC + blk * 128 + 16 * w + 4 * fq);
        const u32x2 vv = *(const u32x2*)(vbase + (size_t)(n * 64 + vtok) * 512 + vdv);
        LAS unsigned char* STs = lds + (n & 1) * 8704;
        LAS unsigned char* VTs = lds + 17408 + (n & 1) * 4608;
#pragma unroll
        for (int c = 0; c < 2; ++c) { const f32x4 v = sacc[c];
            *(LAS u32x2*)(STs + (16 * c + fr) * 272 + (16 * w + 4 * fq) * 2) = (u32x2){g8::cvt_pk_bf16(v[0], v[1]), g8::cvt_pk_bf16(v[2], v[3])}; }
        *(LAS unsigned short*)(VTs + (vdv + 0) * 144 + vtok * 2) = (unsigned short)(vv.x & 0xffffu); *(LAS unsigned short*)(VTs + (vdv + 1) * 144 + vtok * 2) = (unsigned short)(vv.x >> 16);
        *(LAS unsigned short*)(VTs + (vdv + 2) * 144 + vtok * 2) = (unsigned short)(vv.y & 0xffffu); *(LAS unsigned short*)(VTs + (vdv + 3) * 144 + vtok * 2) = (unsigned short)(vv.y >> 16);
        __syncthreads();
        f32x4 o = (f32x4){0.f, 0.f, 0.f, 0.f};
#pragma unroll
        for (int ks = 0; ks < 4; ++ks) { const bf16x8 sb = *(const LAS bf16x8*)(STs + (16 * cto + fr) * 272 + (32 * ks + 8 * fq) * 2); o = mfma16(sb, qf[ks], o); }
        bf16x8 vb[2][2];
#pragma unroll
        for (int c = 0; c < 2; ++c)
#pragma unroll
            for (int k2 = 0; k2 < 2; ++k2) vb[c][k2] = *(const LAS bf16x8*)(VTs + (16 * c + fr) * 144 + (32 * k2 + 8 * fq) * 2);
#pragma unroll
        for (int k2 = 0; k2 < 2; ++k2) o = mfma16(vb[cto][k2], af[k2], o);
#pragma unroll
        for (int c = 0; c < 2; ++c) { f32x4 t = sacc[c] * dec;
#pragma unroll
            for (int k2 = 0; k2 < 2; ++k2) t = mfma16(kf[k2], vb[c][k2], t);
            sacc[c] = t; }
        *(u32x2*)(obase + (size_t)(n * 64 + 16 * rt + fr) * 1024 + 16 * cto + 4 * fq) = (u32x2){g8::cvt_pk_bf16(o[0], o[1]), g8::cvt_pk_bf16(o[2], o[3])};
    }
}


__device__ __forceinline__ void gdn_prep_item(const Args& a, LAS unsigned char* lds, int it) {
    unsigned char* ws = a.ws;
    const bf16_t* GQ = (const bf16_t*)(ws + WS_P); const bf16_t* GK = (const bf16_t*)(ws + WS_P + GRP0); const bf16_t* GV = (const bf16_t*)(ws + WS_P + 2 * GRP0);
    const float* GATES = (const float*)(ws + WS_GATES); const float* cw = a.in[4];
    LAS unsigned char* KNs = lds; LAS unsigned char* QSs = lds + 17408;
    LAS float* AF = (LAS float*)(lds + 34816); LAS float* TF = (LAS float*)(lds + 51456);
    LAS float* MT = (LAS float*)(lds + 68096);
    LAS unsigned char* TBs = lds + 71360;
    LAS unsigned char* VBTs = lds + 80576; LAS unsigned char* KGTs = lds + 99008;
    LAS unsigned char* ATs = lds + 117440;
    LAS float* gcs = (LAS float*)(lds + 126656); LAS float* bes = gcs + 64; LAS float* nqs = bes + 64; LAS float* nks = nqs + 64; LAS float* part = nks + 64;
    LAS unsigned char* WSs = lds + 34816;
    LAS unsigned char* KDTs = VBTs;
    int tid_ = threadIdx.x; asm volatile("" : "+v"(tid_)); const int tid = tid_, lane = tid & 63, w = tid >> 6, fr = lane & 15, fq = lane >> 4;
    const int seg = tid >> 7, c = tid & 127;
    const int b = it >> 8, h = (it >> 6) & 3, n = it & 63;
    const size_t tok0 = (size_t)b * SEQ + n * 64;
    float q[16], k[16], v[16];
    {
        const int ch = h * 128 + c;
#pragma unroll
        for (int mtx = 0; mtx < 3; ++mtx) {
            const bf16_t* src = (mtx == 0 ? GQ : (mtx == 1 ? GK : GV)) + ch;
            float wj[4];
#pragma unroll
            for (int j = 0; j < 4; ++j) wj[j] = cw[j * 1536 + mtx * 512 + ch];
            float x[19];
#pragma unroll
            for (int r = 0; r < 19; ++r) { const int tt = n * 64 + 16 * seg - 3 + r; x[r] = tt >= 0 ? bf2f(src[((size_t)b * SEQ + tt) * 512]) : 0.f; }
#pragma unroll
            for (int i = 0; i < 16; ++i) { const float s = x[i] * wj[0] + x[i + 1] * wj[1] + x[i + 2] * wj[2] + x[i + 3] * wj[3]; const float y = siluf_(s);
                if (mtx == 0) q[i] = y; else if (mtx == 1) k[i] = y; else v[i] = y; }
        }
    }
#pragma unroll
    for (int i = 0; i < 16; ++i) { const float sq = wave_sum(q[i] * q[i]), sk = wave_sum(k[i] * k[i]); if (lane == 0) { part[w * 32 + 2 * i] = sq; part[w * 32 + 2 * i + 1] = sk; } }
    if (tid < 64) {
        const float be = GATES[(tok0 + tid) * 8 + h]; float g = GATES[(tok0 + tid) * 8 + 4 + h];
#pragma unroll
        for (int o = 1; o < 64; o <<= 1) { const float t = __shfl_up(g, o); if (lane >= o) g += t; }
        gcs[tid] = g; bes[tid] = be;
    }
    __syncthreads();
    if (tid < 64) { const int sg = tid >> 4, i = tid & 15; nqs[tid] = rsqrtf(part[(2 * sg) * 32 + 2 * i] + part[(2 * sg + 1) * 32 + 2 * i] + 1e-6f); nks[tid] = rsqrtf(part[(2 * sg) * 32 + 2 * i + 1] + part[(2 * sg + 1) * 32 + 2 * i + 1] + 1e-6f); }
    __syncthreads();
    const float glast = gcs[63];
#pragma unroll
    for (int i = 0; i < 16; ++i) { const int t = 16 * seg + i; const float be = bes[t], gc = gcs[t];
        k[i] *= nks[t]; q[i] *= nqs[t] * 0.08838834764831845f;
        const unsigned p0 = g8::cvt_pk_bf16(k[i], q[i]), p1 = g8::cvt_pk_bf16(v[i] * be, k[i] * be * __expf(gc));
        *(LAS unsigned short*)(KNs + t * 272 + c * 2) = (unsigned short)(p0 & 0xffffu); *(LAS unsigned short*)(QSs + t * 272 + c * 2) = (unsigned short)(p0 >> 16);
        *(LAS unsigned short*)(VBTs + c * 144 + t * 2) = (unsigned short)(p1 & 0xffffu); *(LAS unsigned short*)(KGTs + c * 144 + t * 2) = (unsigned short)(p1 >> 16); }
    __syncthreads();
    {
        const int rt = w >> 1; const int i = 16 * rt + fr; const float gi = gcs[i], bi = bes[i];
#pragma unroll
        for (int c2 = 0; c2 < 2; ++c2) { const int ct = 2 * (w & 1) + c2; f32x4 akk = (f32x4){0.f, 0.f, 0.f, 0.f}, aqk = (f32x4){0.f, 0.f, 0.f, 0.f};
            if (ct <= rt) {
#pragma unroll
                for (int ks = 0; ks < 4; ++ks) { const bf16x8 kj = *(const LAS bf16x8*)(KNs + (16 * ct + fr) * 272 + (32 * ks + 8 * fq) * 2);
                    const bf16x8 ki = *(const LAS bf16x8*)(KNs + (16 * rt + fr) * 272 + (32 * ks + 8 * fq) * 2); const bf16x8 qi = *(const LAS bf16x8*)(QSs + (16 * rt + fr) * 272 + (32 * ks + 8 * fq) * 2);
                    akk = mfma16(kj, ki, akk); aqk = mfma16(kj, qi, aqk); } }
            float at[4];
#pragma unroll
            for (int e = 0; e < 4; ++e) { const int j = 16 * ct + 4 * fq + e; const float dec = (j <= i) ? __expf(gi - gcs[j]) : 0.f;
                AF[i * 65 + j] = (j < i) ? bi * akk[e] * dec : 0.f; at[e] = aqk[e] * dec; }
            *(LAS u32x2*)(ATs + i * 144 + (16 * ct + 4 * fq) * 2) = (u32x2){g8::cvt_pk_bf16(at[0], at[1]), g8::cvt_pk_bf16(at[2], at[3])}; }
    }
    __syncthreads();
    if (tid < 64) {
        const int blk = tid >> 4, cc = tid & 15; float x[16];
#pragma unroll
        for (int r = 0; r < 16; ++r) { float s2 = (r == cc) ? 1.f : 0.f;
#pragma unroll
            for (int j = 0; j < 16; ++j) if (j < r) s2 -= AF[(16 * blk + r) * 65 + 16 * blk + j] * x[j];
            x[r] = s2; TF[(16 * blk + r) * 65 + 16 * blk + cc] = s2; }
    }
    __syncthreads();
#pragma unroll 1
    for (int d = 1; d < 4; ++d) {
        const int nb = 4 - d;
        for (int idx = tid; idx < nb * 256; idx += NTHREADS) { const int j = idx >> 8, r = (idx >> 4) & 15, cc = idx & 15, i = j + d; float m = 0.f;
            for (int kb = j; kb < i; ++kb)
#pragma unroll
                for (int mm = 0; mm < 16; ++mm) m = fmaf(AF[(16 * i + r) * 65 + 16 * kb + mm], TF[(16 * kb + mm) * 65 + 16 * j + cc], m);
            MT[(j * 16 + r) * 17 + cc] = m; }
        __syncthreads();
        for (int idx = tid; idx < nb * 256; idx += NTHREADS) { const int j = idx >> 8, r = (idx >> 4) & 15, cc = idx & 15, i = j + d; float t = 0.f;
#pragma unroll
            for (int mm = 0; mm < 16; ++mm) t = fmaf(TF[(16 * i + r) * 65 + 16 * i + mm], MT[(j * 16 + mm) * 17 + cc], t);
            TF[(16 * i + r) * 65 + 16 * j + cc] = -t; }
        __syncthreads();
    }
    for (int e = tid; e < 64 * 32; e += NTHREADS) { const int i = e >> 5, j = (e & 31) * 2;
        const float t0 = (j >> 4) <= (i >> 4) ? TF[i * 65 + j] : 0.f, t1 = ((j + 1) >> 4) <= (i >> 4) ? TF[i * 65 + j + 1] : 0.f;
        *(LAS unsigned*)(TBs + i * 144 + j * 2) = g8::cvt_pk_bf16(t0, t1); }
    __syncthreads();
    {
        bf16_t* Ud = (bf16_t*)(ws + WS_GU) + (size_t)it * 8192;
        bf16x8 vbf[2], kgf[2];
#pragma unroll
        for (int k2 = 0; k2 < 2; ++k2) { vbf[k2] = *(const LAS bf16x8*)(VBTs + (16 * w + fr) * 144 + (32 * k2 + 8 * fq) * 2); kgf[k2] = *(const LAS bf16x8*)(KGTs + (16 * w + fr) * 144 + (32 * k2 + 8 * fq) * 2); }
#pragma unroll
        for (int rt = 0; rt < 4; ++rt) { f32x4 au = (f32x4){0.f, 0.f, 0.f, 0.f}, aw = (f32x4){0.f, 0.f, 0.f, 0.f};
#pragma unroll
            for (int k2 = 0; k2 < 2; ++k2) { const bf16x8 tf = *(const LAS bf16x8*)(TBs + (16 * rt + fr) * 144 + (32 * k2 + 8 * fq) * 2); au = mfma16(tf, vbf[k2], au); aw = mfma16(kgf[k2], tf, aw); }
            *(u32x2*)(Ud + ((rt * 8 + w) * 64 + lane) * 4) = (u32x2){g8::cvt_pk_bf16(au[0], au[1]), g8::cvt_pk_bf16(au[2], au[3])};
            *(LAS u32x2*)(WSs + (16 * rt + fr) * 272 + (16 * w + 4 * fq) * 2) = (u32x2){g8::cvt_pk_bf16(-aw[0], -aw[1]), g8::cvt_pk_bf16(-aw[2], -aw[3])}; }
    }
    __syncthreads();
#pragma unroll
    for (int i = 0; i < 16; ++i) { const int t = 16 * seg + i; const float gc = gcs[t];
        const unsigned p0 = g8::cvt_pk_bf16(q[i] * __expf(gc), k[i] * __expf(glast - gc));
        *(LAS unsigned short*)(QSs + t * 272 + c * 2) = (unsigned short)(p0 & 0xffffu); *(LAS unsigned short*)(KDTs + c * 144 + t * 2) = (unsigned short)(p0 >> 16); }
    __syncthreads();
    {   u32x4* qdst = (u32x4*)((bf16_t*)(ws + WS_GQG) + (size_t)it * 8192); u32x4* kdst = (u32x4*)((bf16_t*)(ws + WS_GKDT) + (size_t)it * 8192);
        u32x4* wdst = (u32x4*)((bf16_t*)(ws + WS_GWN) + (size_t)it * 8192); u32x4* adst = (u32x4*)((bf16_t*)(ws + WS_GATT) + (size_t)it * 4096);
#pragma unroll
        for (int i = 0; i < 2; ++i) { const int q2 = tid + 512 * i, tile = q2 >> 6, l = q2 & 63;
            { const int rt = tile >> 2, ks = tile & 3; qdst[q2] = *(const LAS u32x4*)(QSs + (16 * rt + (l & 15)) * 272 + (32 * ks + 8 * (l >> 4)) * 2); wdst[q2] = *(const LAS u32x4*)(WSs + (16 * rt + (l & 15)) * 272 + (32 * ks + 8 * (l >> 4)) * 2); }
            { const int rt = tile >> 1, ks = tile & 1; kdst[q2] = *(const LAS u32x4*)(KDTs + (16 * rt + (l & 15)) * 144 + (32 * ks + 8 * (l >> 4)) * 2); } }
        { const int tile = tid >> 6, l = tid & 63; const int rt = tile >> 1, ks = tile & 1; adst[tid] = *(const LAS u32x4*)(ATs + (16 * rt + (l & 15)) * 144 + (32 * ks + 8 * (l >> 4)) * 2); }
        if (tid == 0) ((float*)(ws + WS_GEG))[it] = __expf(glast);
    }
    __syncthreads();
}

__device__ __forceinline__ void gdn_scan_item(const Args& a, LAS unsigned char* lds, int idx) {
    unsigned char* ws = a.ws;
    const bf16_t* QG = (const bf16_t*)(ws + WS_GQG); const bf16_t* KDT = (const bf16_t*)(ws + WS_GKDT); const bf16_t* WN = (const bf16_t*)(ws + WS_GWN); const bf16_t* ATT = (const bf16_t*)(ws + WS_GATT);
    const bf16_t* U = (const bf16_t*)(ws + WS_GU); const float* EG = (const float*)(ws + WS_GEG); bf16_t* O = (bf16_t*)(ws + WS_O0);
    int tid_ = threadIdx.x; asm volatile("" : "+v"(tid_)); const int tid = tid_, lane = tid & 63, w = __builtin_amdgcn_readfirstlane(tid >> 6), fr = lane & 15, fq = lane >> 4;
    const int bh = (idx & 7) | (((idx >> 5) & 1) << 3), sl = (idx >> 3) & 3, b = bh >> 2, h = bh & 3;
    const int rt = w >> 1, ct = w & 1;
    f32x4 sacc[2];
    sacc[0] = (f32x4){0.f, 0.f, 0.f, 0.f}; sacc[1] = (f32x4){0.f, 0.f, 0.f, 0.f};
    bf16_t* obase = O + ((size_t)b * SEQ) * 1024 + h * 128 + sl * 32;
    LAS unsigned char* STs = lds;
    LAS unsigned char* VTs = lds + 8704;
    for (int n = 0; n < 64; ++n) {
        const size_t blk = (size_t)bh * 64 + n;
        const bf16x8* qb = (const bf16x8*)(QG + blk * 8192) + lane; const bf16x8* wb = (const bf16x8*)(WN + blk * 8192) + lane;
        const bf16x8* kb = (const bf16x8*)(KDT + blk * 8192) + lane; const bf16x8* ab = (const bf16x8*)(ATT + blk * 4096) + lane;
        bf16x8 qf[4], wf[4], af[2], kf[2];
#pragma unroll
        for (int ks = 0; ks < 4; ++ks) { qf[ks] = qb[(rt * 4 + ks) * 64]; wf[ks] = wb[(rt * 4 + ks) * 64]; }
#pragma unroll
        for (int k2 = 0; k2 < 2; ++k2) { af[k2] = ab[(rt * 2 + k2) * 64]; kf[k2] = kb[(w * 2 + k2) * 64]; }
        const u32x2 uu = *(const u32x2*)(U + blk * 8192 + ((rt * 8 + sl * 2 + ct) * 64 + lane) * 4);
        const float eg = EG[blk];
#pragma unroll
        for (int c = 0; c < 2; ++c) { const f32x4 v = sacc[c];
            *(LAS u32x2*)(STs + (16 * c + fr) * 272 + (16 * w + 4 * fq) * 2) = (u32x2){g8::cvt_pk_bf16(v[0], v[1]), g8::cvt_pk_bf16(v[2], v[3])}; }
        __syncthreads();
        f32x4 vn = (f32x4){__uint_as_float(uu.x << 16), __uint_as_float(uu.x & 0xffff0000u), __uint_as_float(uu.y << 16), __uint_as_float(uu.y & 0xffff0000u)};
        f32x4 o = (f32x4){0.f, 0.f, 0.f, 0.f};
#pragma unroll
        for (int ks = 0; ks < 4; ++ks) { const bf16x8 sb = *(const LAS bf16x8*)(STs + (16 * ct + fr) * 272 + (32 * ks + 8 * fq) * 2); vn = mfma16(wf[ks], sb, vn); o = mfma16(sb, qf[ks], o); }
        *(LAS u32x2*)(VTs + (16 * ct + fr) * 144 + (16 * rt + 4 * fq) * 2) = (u32x2){g8::cvt_pk_bf16(vn[0], vn[1]), g8::cvt_pk_bf16(vn[2], vn[3])};
        __syncthreads();
        bf16x8 vb[2][2];
#pragma unroll
        for (int c = 0; c < 2; ++c)
#pragma unroll
            for (int k2 = 0; k2 < 2; ++k2) vb[c][k2] = *(const LAS bf16x8*)(VTs + (16 * c + fr) * 144 + (32 * k2 + 8 * fq) * 2);
#pragma unroll
        for (int k2 = 0; k2 < 2; ++k2) o = mfma16(vb[ct][k2], af[k2], o);
#pragma unroll
        for (int c = 0; c < 2; ++c) { f32x4 t = sacc[c] * eg;
#pragma unroll
            for (int k2 = 0; k2 < 2; ++k2) t = mfma16(kf[k2], vb[c][k2], t);
            sacc[c] = t; }
        *(u32x2*)(obase + (size_t)(n * 64 + 16 * rt + fr) * 1024 + 16 * ct + 4 * fq) = (u32x2){g8::cvt_pk_bf16(o[0], o[1]), g8::cvt_pk_bf16(o[2], o[3])};
    }
}


__device__ __forceinline__ void phase_mix0_prep(const Args& a, LAS unsigned char* lds) {
    for (int it = blockIdx.x; it < 1024; it += gridDim.x) gdn_prep_item(a, lds, it);
    for (int it = blockIdx.x; it < 1024; it += gridDim.x) hgrn_prep_item(a, lds, it);
}
__device__ __forceinline__ void phase_mix0_scan(const Args& a, LAS unsigned char* lds) {
    if (blockIdx.x < 64) gdn_scan_item(a, lds, (int)blockIdx.x);
    else if (blockIdx.x >= 128 && blockIdx.x < 192) hgrn_scan_item(a, lds, (int)blockIdx.x - 128);
}

__device__ __forceinline__ void phase_post1(const Args& a) {
    unsigned char* ws = a.ws;
    bf16_t* O = (bf16_t*)(ws + WS_PV); const bf16_t* G = (const bf16_t*)(ws + WS_PG);
    const float* nw = a.in[12];
    const int lane = threadIdx.x & 63, wave = threadIdx.x >> 6;
    for (int m = blockIdx.x * NWAVES + wave; m < NTOK; m += gridDim.x * NWAVES) {
        float v[32], z[32]; float s = 0.f;
#pragma unroll
        for (int q = 0; q < 4; ++q) {
            const u32x4 o = *((const u32x4*)(O + (size_t)m * 2048 + 32 * lane) + q); const u32x4 zz = *((const u32x4*)(G + (size_t)m * 2048 + 32 * lane) + q);
            const unsigned ow[4] = {o.x, o.y, o.z, o.w}; const unsigned zw[4] = {zz.x, zz.y, zz.z, zz.w};
#pragma unroll
            for (int i = 0; i < 4; ++i) { v[8 * q + 2 * i] = __uint_as_float(ow[i] << 16); v[8 * q + 2 * i + 1] = __uint_as_float(ow[i] & 0xffff0000u);
                z[8 * q + 2 * i] = __uint_as_float(zw[i] << 16); z[8 * q + 2 * i + 1] = __uint_as_float(zw[i] & 0xffff0000u); }
        }
#pragma unroll
        for (int i = 0; i < 32; ++i) s += v[i] * v[i];
        s += __shfl_xor(s, 1); s += __shfl_xor(s, 2); s += __shfl_xor(s, 4); s += __shfl_xor(s, 8);
        const float rs = rsqrtf(s * (1.f / 512.f) + 1e-6f);
#pragma unroll
        for (int q = 0; q < 4; ++q) {
            unsigned r[4];
#pragma unroll
            for (int i = 0; i < 4; ++i) { const int j = 8 * q + 2 * i; const int c0 = (32 * lane + j) & 511;
                r[i] = g8::cvt_pk_bf16(v[j] * rs * nw[c0] * siluf_(z[j]), v[j + 1] * rs * nw[c0 + 1] * siluf_(z[j + 1])); }
            *((u32x4*)(O + (size_t)m * 2048 + 32 * lane) + q) = (u32x4){r[0], r[1], r[2], r[3]};
        }
    }
}


#define GRID_SYNC() do { asm volatile("s_waitcnt vmcnt(0)" ::: "memory"); grid.sync(); \
    if (threadIdx.x == 0) { __builtin_amdgcn_fence(__ATOMIC_ACQUIRE, "agent"); asm volatile("s_waitcnt vmcnt(0)" ::: "memory"); } \
    __syncthreads(); } while (0)

__global__ void __launch_bounds__(NTHREADS, 2) mega(Args a) {
    extern __shared__ __attribute__((aligned(16))) unsigned char lds_raw[];
    LAS unsigned char* lds = (LAS unsigned char*)lds_raw;
    cg::grid_group grid = cg::this_grid();
    unsigned char* ws = a.ws;
    const int G = gridDim.x, c = blockIdx.x;

    phase_prep(a, lds);
    GRID_SYNC();
    {
        g8::DenseOrder S{(const char*)(ws + WS_XB), (const char*)(ws + WS_WIN0), 2048, 2048, NTOK / 256, 16, G, c};
        g8::EpiGroups E{(bf16_t*)(ws + WS_P), (const float*)(ws + WS_RS), 2, 512, GRP0 / 2};
        g8::gemm_phase<g8::EpiGroups, g8::DenseOrder>(lds, 2048, 2048, 1024, S, E);
    }
    GRID_SYNC();
    phase_mix0_prep(a, lds);
    GRID_SYNC();
    phase_mix0_scan(a, lds);
    GRID_SYNC();
    phase_post0(a);
    moe_weight_items(a, 0, lds);
    odd_weight_items(a, lds);
    GRID_SYNC();
    {
        g8::DenseOrder S{(const char*)(ws + WS_O0), (const char*)(ws + WS_WOUT0), 2048, 2048, NTOK / 256, 4, G, c};
        g8::EpiRes E{a.in[0], a.out, (bf16_t*)(ws + WS_XB)};
        g8::gemm_phase<g8::EpiRes, g8::DenseOrder>(lds, 2048, 2048, 1024, S, E);
    }
    GRID_SYNC();
#define MOE_LAYER(layer) do { \
    phase_route(a, layer, lds); \
    GRID_SYNC(); \
    moe_table(a, layer, lds); \
    {   g8::MoeOrder S{(const char*)(ws + WS_XB), (const char*)(ws + WS_WGU), (const int4*)(ws + WS_ROWREC), (LAS const int*)(lds + LDS_TAB), 0, G, c}; \
        g8::EpiGU E{(bf16_t*)(ws + WS_ACT), (const int4*)(ws + WS_ROWREC)}; \
        g8::gemm_phase<g8::EpiGU, g8::MoeOrder, true>(lds, 2048, 2048, 1024, S, E); } \
    GRID_SYNC(); \
    {   g8::MoeOrder S{(const char*)(ws + WS_ACT), (const char*)(ws + WS_WDN), (const int4*)(ws + WS_ROWREC), (LAS const int*)(lds + LDS_TAB), 1, G, c}; \
        g8::EpiDown E{a.out, (bf16_t*)(ws + WS_XB), (float*)(ws + WS_ROWSS) + (size_t)(layer) * NTOK * 16, (const int4*)(ws + WS_ROWREC)}; \
        g8::gemm_phase<g8::EpiDown, g8::MoeOrder, false>(lds, 1024, 1024, 512, S, E); } \
    GRID_SYNC(); } while (0)
    MOE_LAYER(0);
    {
        g8::DenseOrder S{(const char*)(ws + WS_XB), (const char*)(ws + WS_WIN1), 2048, 2048, NTOK / 256, 24, G, c};
        g8::EpiOdd E{(bf16_t*)(ws + WS_PQ), (bf16_t*)(ws + WS_PK), (bf16_t*)(ws + WS_PV), (bf16_t*)(ws + WS_PG), (const float*)(ws + WS_ROWSS)};
        g8::gemm_phase<g8::EpiOdd, g8::DenseOrder>(lds, 2048, 2048, 1024, S, E);
    }
    GRID_SYNC();
    phase_ret_prep(a, lds);
    GRID_SYNC();
    phase_ret_scan(a, lds);
    GRID_SYNC();
    phase_post1(a);
    moe_weight_items(a, 1, lds);
    GRID_SYNC();
    {
        g8::DenseOrder S{(const char*)(ws + WS_PV), (const char*)(ws + WS_WOUT1), 4096, 4096, NTOK / 256, 4, G, c};
        g8::EpiRes E{a.out, a.out, (bf16_t*)(ws + WS_XB)};
        g8::gemm_phase<g8::EpiRes, g8::DenseOrder>(lds, 4096, 4096, 2048, S, E);
    }
    GRID_SYNC();
    MOE_LAYER(1);
    phase_final(a);
}

extern "C" void kernel_launch(void* const* d_in, const int* in_sizes, int n_in, void* d_out, int out_size, void* d_ws, size_t ws_size, hipStream_t stream) {
    static int grid_blocks = 0;
    if (!grid_blocks) {
        if (ws_size < WS_END || n_in != 21) { fprintf(stderr, "kernel_launch: ws %zu < %zu or n_in %d\n", ws_size, (size_t)WS_END, n_in); grid_blocks = -1; return; }
        int dev = 0, cus = 0, per_cu = 0;
        (void)hipGetDevice(&dev);
        (void)hipDeviceGetAttribute(&cus, hipDeviceAttributeMultiprocessorCount, dev);
        (void)hipFuncSetAttribute((const void*)mega, hipFuncAttributeMaxDynamicSharedMemorySize, LDS_BYTES);
        (void)hipOccupancyMaxActiveBlocksPerMultiprocessor(&per_cu, (const void*)mega, NTHREADS, LDS_BYTES);
        if (per_cu < 1) { fprintf(stderr, "kernel_launch: occupancy query says %d blocks per CU\n", per_cu); grid_blocks = -1; return; }
        grid_blocks = cus;
    }
    if (grid_blocks < 0) return;
    Args a{};
    for (int i = 0; i < 21; ++i) a.in[i] = (const float*)d_in[i];
    a.out = (float*)d_out; a.ws = (unsigned char*)d_ws;
    void* args[] = {&a};
    hipError_t e = hipLaunchCooperativeKernel((const void*)mega, dim3(grid_blocks), dim3(NTHREADS), args, LDS_BYTES, stream);
    if (e != hipSuccess) fprintf(stderr, "cooperative launch failed: %s (grid %d)\n", hipGetErrorString(e), grid_blocks);
}
```
